# Optimizing an MI355X kernel written in HIP

```python
import jax
import jax.numpy as jnp
from jax import lax
import numpy as np


D_MODEL = 1024
BATCH = 8
SEQ = 4096
DEPTH = 2

GRID_W = 64
CTX_LEN = 256
HEAD_DIM = 64
A_HEADS = 8
A_KV_HEADS = 2
WINDOW = 128
A_BLOCK = 128
A_WIDTH = A_HEADS * HEAD_DIM
A_KV_WIDTH = A_KV_HEADS * HEAD_DIM
A_IN = A_WIDTH + 2 * A_KV_WIDTH
B_GROUPS = 8
B_WIDTH = 512
B_GROUP_DIM = B_WIDTH // B_GROUPS
CHUNK = 128
AB_IN = A_IN + 2 * B_WIDTH
AB_OUT = A_WIDTH + B_WIDTH
C_HEADS = 16
C_WIDTH = C_HEADS * HEAD_DIM
NA_ROWS = 8
NA_COLS = 16
NA_COL_BLOCK = 16
NA_KEY_COLS = 32
RPB_R = 2 * NA_ROWS - 1
RPB_C = 2 * NA_COLS - 1
D_FF = 4 * D_MODEL
ROPE_BASE = 10000.0
LN_EPS = 1e-5
NEG_INF = -1e30
DEEPNORM_ALPHA = (2 * DEPTH) ** 0.25
DEEPNORM_BETA = (8 * DEPTH) ** -0.25
N_EVEN = (DEPTH + 1) // 2
N_ODD = DEPTH // 2

kernel_name = 'hybrid_window_gmlp_natten_prefix_dit'


def _layer_norm(x, g, b):
    xf = x.astype(jnp.float32)
    mu = jnp.mean(xf, axis=-1, keepdims=True)
    var = jnp.mean(jnp.square(xf - mu), axis=-1, keepdims=True)
    y = (xf - mu) * lax.rsqrt(var + LN_EPS)
    return (y * g.astype(jnp.float32) + b.astype(jnp.float32)).astype(x.dtype)


def _modulation(cond, w, b):
    return jnp.split(jax.nn.silu(cond) @ w + b, 6, axis=-1)


def _axial_rope(n_tok):
    t = jnp.arange(n_tok)
    row = (t // GRID_W).astype(jnp.float32)
    col = (t % GRID_W).astype(jnp.float32)
    n_pairs = HEAD_DIM // 4
    freqs = ROPE_BASE ** (-jnp.arange(n_pairs, dtype=jnp.float32) / n_pairs)
    ang = jnp.concatenate([row[:, None] * freqs, col[:, None] * freqs], axis=-1)
    return jnp.cos(ang), jnp.sin(ang)


def _apply_rope(x, cos, sin):
    xf = x.astype(jnp.float32)
    x1, x2 = xf[..., 0::2], xf[..., 1::2]
    cc, ss = cos[:, None, :], sin[:, None, :]
    out = jnp.stack([x1 * cc - x2 * ss, x1 * ss + x2 * cc], axis=-1).reshape(x.shape)
    return out.astype(x.dtype)


def _joint_softmax(s_loc, s_ctx, s_sink=None):
    m = jnp.maximum(jnp.max(s_loc, axis=-1, keepdims=True), jnp.max(s_ctx, axis=-1, keepdims=True))
    if s_sink is not None:
        m = jnp.maximum(m, s_sink)
    e_loc = jnp.exp(s_loc - m)
    e_ctx = jnp.exp(s_ctx - m)
    denom = jnp.sum(e_loc, axis=-1, keepdims=True) + jnp.sum(e_ctx, axis=-1, keepdims=True)
    if s_sink is not None:
        denom = denom + jnp.exp(s_sink - m)
    return e_loc / denom, e_ctx / denom


def _context_attention(qc, kc, vc, sink):
    B, L, H, D = qc.shape
    hkv = kc.shape[2]
    g = H // hkv
    qg = qc.reshape(B, L, hkv, g, D)
    s = jnp.einsum('bqhgd,bkhd->bhgqk', qg, kc).astype(jnp.float32) * (D ** -0.5)
    if sink is not None:
        s_sink = jnp.broadcast_to(sink.astype(jnp.float32).reshape(hkv, g)[None, :, :, None, None], (B, hkv, g, L, 1))
        s = jnp.concatenate([s, s_sink], axis=-1)
    p = jax.nn.softmax(s, axis=-1)[..., :L].astype(vc.dtype)
    o = jnp.einsum('bhgqk,bkhd->bqhgd', p, vc)
    return o.reshape(B, L, H * D)


def _window_attention(q, k, v, kc, vc, sink):
    B, S, H, D = q.shape
    hkv = k.shape[2]
    g = H // hkv
    nb = S // A_BLOCK
    nk = 3 * A_BLOCK
    scale = D ** -0.5
    qb = q.reshape(B, nb, A_BLOCK, hkv, g, D)
    pad = ((0, 0), (A_BLOCK, A_BLOCK), (0, 0), (0, 0))
    kp = jnp.pad(k, pad).reshape(B, nb + 2, A_BLOCK, hkv, D)
    vp = jnp.pad(v, pad).reshape(B, nb + 2, A_BLOCK, hkv, D)
    kw = jnp.concatenate([kp[:, :-2], kp[:, 1:-1], kp[:, 2:]], axis=2)
    vw = jnp.concatenate([vp[:, :-2], vp[:, 1:-1], vp[:, 2:]], axis=2)
    qpos = np.arange(nb)[:, None, None] * A_BLOCK + np.arange(A_BLOCK)[None, :, None]
    kpos = np.arange(nb)[:, None, None] * A_BLOCK - A_BLOCK + np.arange(nk)[None, None, :]
    band = (np.abs(qpos - kpos) <= WINDOW) & (kpos >= 0) & (kpos < S)
    s_loc = jnp.einsum('bnqhgd,bnkhd->bhgnqk', qb, kw).astype(jnp.float32) * scale
    s_loc = jnp.where(band, s_loc, NEG_INF)
    s_ctx = jnp.einsum('bnqhgd,bkhd->bhgnqk', qb, kc).astype(jnp.float32) * scale
    s_sink = sink.astype(jnp.float32).reshape(hkv, g)[None, :, :, None, None, None]
    p_loc, p_ctx = _joint_softmax(s_loc, s_ctx, s_sink)
    o = (jnp.einsum('bhgnqk,bnkhd->bnqhgd', p_loc.astype(v.dtype), vw)
         + jnp.einsum('bhgnqk,bkhd->bnqhgd', p_ctx.astype(v.dtype), vc))
    return o.reshape(B, S, H * D)


def _spatial_gating(u, gv, ln_g, ln_b, w_s, b_s):
    B, S, _ = u.shape
    nc = S // CHUNK
    vn = _layer_norm(gv, ln_g, ln_b).reshape(B, nc, CHUNK, B_GROUPS, B_GROUP_DIM)
    mixed = jnp.einsum('gpq,bnqgc->bnpgc', w_s, vn) + b_s.T[None, None, :, :, None]
    return u * mixed.reshape(B, S, B_WIDTH)


def _mixer_ab(h, hc, w_in, w_out, sink, ln_g, ln_b, w_s, b_s, cos, sin, need_ctx_out):
    B, S, _ = h.shape
    L = hc.shape[1]
    z = h @ w_in
    q = _apply_rope(z[..., :A_WIDTH].reshape(B, S, A_HEADS, HEAD_DIM), cos, sin)
    k = _apply_rope(z[..., A_WIDTH:A_WIDTH + A_KV_WIDTH].reshape(B, S, A_KV_HEADS, HEAD_DIM), cos, sin)
    v = z[..., A_WIDTH + A_KV_WIDTH:A_IN].reshape(B, S, A_KV_HEADS, HEAD_DIM)
    u = jax.nn.gelu(z[..., A_IN:A_IN + B_WIDTH], approximate=False)
    gv = jax.nn.gelu(z[..., A_IN + B_WIDTH:], approximate=False)
    zkv = hc @ w_in[:, A_WIDTH:A_IN]
    kc = zkv[..., :A_KV_WIDTH].reshape(B, L, A_KV_HEADS, HEAD_DIM)
    vc = zkv[..., A_KV_WIDTH:].reshape(B, L, A_KV_HEADS, HEAD_DIM)
    a_out = _window_attention(q, k, v, kc, vc, sink)
    b_out = _spatial_gating(u, gv, ln_g, ln_b, w_s, b_s)
    y = jnp.concatenate([a_out, b_out], axis=-1) @ w_out
    yc = None
    if need_ctx_out:
        qc = (hc @ w_in[:, :A_WIDTH]).reshape(B, L, A_HEADS, HEAD_DIM)
        zc = hc @ w_in[:, A_IN:]
        uc = jax.nn.gelu(zc[..., :B_WIDTH], approximate=False)
        gvc = jax.nn.gelu(zc[..., B_WIDTH:], approximate=False)
        ac_out = _context_attention(qc, kc, vc, sink)
        bc_out = _spatial_gating(uc, gvc, ln_g, ln_b, w_s, b_s)
        yc = jnp.concatenate([ac_out, bc_out], axis=-1) @ w_out
    return y, yc


def _neighbourhood_attention(q, k, v, kc, vc, rpb):
    B, S, H, D = q.shape
    rows = S // GRID_W
    kh = min(NA_ROWS, rows)
    n_cb = GRID_W // NA_COL_BLOCK
    scale = D ** -0.5
    qcol = np.arange(GRID_W).reshape(n_cb, NA_COL_BLOCK)
    q_start = np.clip(qcol - NA_COLS // 2, 0, GRID_W - NA_COLS)
    k_start = np.clip(np.arange(n_cb) * NA_COL_BLOCK - NA_COLS // 2, 0, GRID_W - NA_KEY_COLS)
    key_cols = k_start[:, None] + np.arange(NA_KEY_COLS)[None, :]
    kcb = key_cols[:, None, :]
    col_ok = (kcb >= q_start[..., None]) & (kcb < q_start[..., None] + NA_COLS)
    mask = np.broadcast_to(col_ok[:, :, None, :], (n_cb, NA_COL_BLOCK, kh, NA_KEY_COLS)).reshape(n_cb, NA_COL_BLOCK, kh * NA_KEY_COLS)
    dc_idx = np.clip(kcb - qcol[..., None] + NA_COLS - 1, 0, RPB_C - 1)
    qg = q.reshape(B, rows, n_cb, NA_COL_BLOCK, H, D)
    kg = k.reshape(B, rows, GRID_W, H, D)
    vg = v.reshape(B, rows, GRID_W, H, D)

    def row_block(r):
        r0 = jnp.clip(r - kh // 2, 0, rows - kh)
        k_rows = lax.dynamic_slice_in_dim(kg, r0, kh, axis=1)
        v_rows = lax.dynamic_slice_in_dim(vg, r0, kh, axis=1)
        kb = k_rows[:, :, key_cols].transpose(0, 2, 1, 3, 4, 5).reshape(B, n_cb, kh * NA_KEY_COLS, H, D)
        vb = v_rows[:, :, key_cols].transpose(0, 2, 1, 3, 4, 5).reshape(B, n_cb, kh * NA_KEY_COLS, H, D)
        qr = lax.dynamic_index_in_dim(qg, r, axis=1, keepdims=False)
        dr = r0 + jnp.arange(kh) - r + NA_ROWS - 1
        bias = jnp.take(rpb, dr, axis=1)[:, :, dc_idx]
        bias = bias.transpose(0, 2, 3, 1, 4).reshape(H, n_cb, NA_COL_BLOCK, kh * NA_KEY_COLS).astype(jnp.float32)
        s_loc = jnp.einsum('bjqhd,bjkhd->bhjqk', qr, kb).astype(jnp.float32) * scale + bias
        s_loc = jnp.where(mask, s_loc, NEG_INF)
        s_ctx = jnp.einsum('bjqhd,bkhd->bhjqk', qr, kc).astype(jnp.float32) * scale
        p_loc, p_ctx = _joint_softmax(s_loc, s_ctx)
        o = (jnp.einsum('bhjqk,bjkhd->bjqhd', p_loc.astype(v.dtype), vb)
             + jnp.einsum('bhjqk,bkhd->bjqhd', p_ctx.astype(v.dtype), vc))
        return o.reshape(B, GRID_W, H * D)

    out = lax.map(row_block, jnp.arange(rows))
    return out.transpose(1, 0, 2, 3).reshape(B, S, H * D)


def _mixer_c(h, hc, w_in, w_out, rpb, need_ctx_out):
    B, S, _ = h.shape
    L = hc.shape[1]
    z = h @ w_in
    q = z[..., :C_WIDTH].reshape(B, S, C_HEADS, HEAD_DIM)
    k = z[..., C_WIDTH:2 * C_WIDTH].reshape(B, S, C_HEADS, HEAD_DIM)
    v = z[..., 2 * C_WIDTH:].reshape(B, S, C_HEADS, HEAD_DIM)
    zkv = hc @ w_in[:, C_WIDTH:]
    kc = zkv[..., :C_WIDTH].reshape(B, L, C_HEADS, HEAD_DIM)
    vc = zkv[..., C_WIDTH:].reshape(B, L, C_HEADS, HEAD_DIM)
    y = _neighbourhood_attention(q, k, v, kc, vc, rpb) @ w_out
    yc = None
    if need_ctx_out:
        qc = (hc @ w_in[:, :C_WIDTH]).reshape(B, L, C_HEADS, HEAD_DIM)
        yc = _context_attention(qc, kc, vc, None) @ w_out
    return y, yc


def _squared_relu_mlp(h, w1, w2):
    return jnp.square(jax.nn.relu(h @ w1)) @ w2


def setup_inputs(seed: int = 0) -> dict:
    key = jax.random.key(seed)
    ks = jax.random.split(key, 24)
    f32 = jnp.float32

    def nrm(k, shape, scale):
        return jax.random.normal(k, shape, f32) * scale

    return {
        'x': nrm(ks[0], (BATCH, SEQ, D_MODEL), 1.0),
        'c': nrm(ks[1], (BATCH, D_MODEL), 1.0),
        'ctx': nrm(ks[2], (BATCH, CTX_LEN, D_MODEL), 1.0),
        'c_ctx': nrm(ks[3], (D_MODEL,), 1.0),
        'w_mod': nrm(ks[4], (DEPTH, D_MODEL, 6 * D_MODEL), 0.5 * D_MODEL ** -0.5),
        'b_mod': nrm(ks[5], (DEPTH, 6 * D_MODEL), 0.02),
        'ab_w_in': nrm(ks[6], (N_EVEN, D_MODEL, AB_IN), D_MODEL ** -0.5),
        'a_sink': nrm(ks[7], (N_EVEN, A_HEADS), 1.0),
        'b_ln_g': 1.0 + nrm(ks[8], (N_EVEN, B_WIDTH), 0.02),
        'b_ln_b': nrm(ks[9], (N_EVEN, B_WIDTH), 0.02),
        'b_ws': nrm(ks[10], (N_EVEN, B_GROUPS, CHUNK, CHUNK), CHUNK ** -0.5),
        'b_bs': 1.0 + nrm(ks[11], (N_EVEN, B_GROUPS, CHUNK), 0.02),
        'ab_w_out': nrm(ks[12], (N_EVEN, AB_OUT, D_MODEL), DEEPNORM_BETA * AB_OUT ** -0.5),
        'c_w_in': nrm(ks[13], (N_ODD, D_MODEL, 3 * C_WIDTH), D_MODEL ** -0.5),
        'c_rpb': nrm(ks[14], (N_ODD, C_HEADS, RPB_R, RPB_C), 0.1),
        'c_w_out': nrm(ks[15], (N_ODD, C_WIDTH, D_MODEL), DEEPNORM_BETA * C_WIDTH ** -0.5),
        'ln1_g': 1.0 + nrm(ks[16], (DEPTH, D_MODEL), 0.02),
        'ln1_b': nrm(ks[17], (DEPTH, D_MODEL), 0.02),
        'mlp_w1': nrm(ks[18], (DEPTH, D_MODEL, D_FF), D_MODEL ** -0.5),
        'mlp_w2': nrm(ks[19], (DEPTH, D_FF, D_MODEL), DEEPNORM_BETA * D_FF ** -0.5),
        'ln2_g': 1.0 + nrm(ks[20], (DEPTH, D_MODEL), 0.02),
        'ln2_b': nrm(ks[21], (DEPTH, D_MODEL), 0.02),
    }


def reference(x, c, ctx, c_ctx, w_mod, b_mod, ab_w_in, a_sink, b_ln_g, b_ln_b, b_ws, b_bs, ab_w_out,
              c_w_in, c_rpb, c_w_out, ln1_g, ln1_b, mlp_w1, mlp_w2, ln2_g, ln2_b):
    S = x.shape[1]
    cos, sin = _axial_rope(S)
    for l in range(DEPTH):
        last = l == DEPTH - 1
        i = l // 2
        sh_a, sc_a, g_a, sh_m, sc_m, g_m = [m[:, None, :] for m in _modulation(c, w_mod[l], b_mod[l])]
        csh_a, csc_a, cg_a, csh_m, csc_m, cg_m = _modulation(c_ctx, w_mod[l], b_mod[l])
        h = x * (1 + sc_a) + sh_a
        hc = ctx * (1 + csc_a) + csh_a
        if l % 2 == 0:
            y, yc = _mixer_ab(h, hc, ab_w_in[i], ab_w_out[i], a_sink[i], b_ln_g[i], b_ln_b[i],
                              b_ws[i], b_bs[i], cos, sin, not last)
        else:
            y, yc = _mixer_c(h, hc, c_w_in[i], c_w_out[i], c_rpb[i], not last)
        x = _layer_norm(DEEPNORM_ALPHA * x + g_a * y, ln1_g[l], ln1_b[l])
        x = _layer_norm(DEEPNORM_ALPHA * x + g_m * _squared_relu_mlp(x * (1 + sc_m) + sh_m, mlp_w1[l], mlp_w2[l]),
                        ln2_g[l], ln2_b[l])
        if not last:
            ctx = _layer_norm(DEEPNORM_ALPHA * ctx + cg_a * yc, ln1_g[l], ln1_b[l])
            ctx = _layer_norm(DEEPNORM_ALPHA * ctx + cg_m * _squared_relu_mlp(ctx * (1 + csc_m) + csh_m, mlp_w1[l], mlp_w2[l]),
                              ln2_g[l], ln2_b[l])
    return x
```

```cpp
#include <hip/hip_runtime.h>
#include <hip/hip_cooperative_groups.h>
#include <cstdio>
#include <cstdint>
namespace cg = cooperative_groups;

constexpr int DM = 1024, NBATCH = 8, SEQ = 4096, CTXL = 256;
constexpr int MLAT = NBATCH * SEQ;
constexpr int MCTX = NBATCH * CTXL;
constexpr int MALL = MLAT + MCTX;
constexpr int ABIN = 1792, CIN = 3072, FF = 4096, MODW = 6 * DM;
constexpr float LN_EPS = 1e-5f, ALPHA = 1.41421356237309515f;
namespace pg8 {
#define PG8_LAS __attribute__((address_space(3)))
typedef unsigned short bf16_t;
typedef short bf16x8 __attribute__((ext_vector_type(8)));
typedef float f32x4 __attribute__((ext_vector_type(4)));
typedef unsigned u32x4 __attribute__((ext_vector_type(4)));
constexpr int BM = 256, BK = 64, HALF = 128, HTB = HALF * BK * 2  , STAGE_BYTES = 8 * HTB, NXCD = 8, WGM = 8;

__host__ __device__ __forceinline__ int lds_byte(int r, int c) { const int st = (r >> 4) * 2 + (c >> 5), rr = r & 15, cc = c & 31, ob = rr * 64 + cc * 2; return st * 1024 + (ob ^ (((ob >> 9) & 1) << 5)); }
__host__ __device__ __forceinline__ void stage_rc(int b, int& R, int& C) { const int st = b / 1024, sb = b % 1024, swz = sb ^ (((sb >> 9) & 1) << 5); R = (st >> 1) * 16 + swz / 64; C = (st & 1) * 32 + (swz % 64) / 2; }
__host__ __device__ __forceinline__ int perm32(int rho) { const int n = rho >> 4, i = rho & 15; return 8 * (i >> 2) + 4 * n + (i & 3); }

struct Unit { int pm, pn; };
struct Gemm { const bf16_t* A; const bf16_t* Bt; int M, N, K; };

struct StaticOrder {
    int nM, nN, nwg, G, c;
    __host__ __device__ void init(int M, int N, int G_, int c_) { nM = M / BM; nN = N / BM; nwg = nM * nN; G = G_; c = c_; }
    __host__ __device__ bool next(int i, Unit& u) const {
        const long L = (long)i * G + c; if (L >= nwg) return false;
        int wgid = (int)L; { const int q = nwg / NXCD, r = nwg % NXCD, xcd = wgid % NXCD, off = wgid / NXCD; wgid = (xcd < r ? xcd * (q + 1) : r * (q + 1) + (xcd - r) * q) + off; }
        const int nig = WGM * nN, gid = wgid / nig, fm = gid * WGM, gsz = (nM - fm) < WGM ? (nM - fm) : WGM;
        u.pm = fm + ((wgid % nig) % gsz); u.pn = (wgid % nig) / gsz; return true;
    }
    __device__ __forceinline__ void a_ready(const Unit&) const {}
    __device__ __forceinline__ void done(const Unit&) const {}
};

__device__ __forceinline__ unsigned cvt_pk_bf16(float lo, float hi) { unsigned r; asm volatile("v_cvt_pk_bf16_f32 %0, %1, %2" : "=v"(r) : "v"(lo), "v"(hi)); return r; }
typedef float f32x2 __attribute__((ext_vector_type(2)));
__device__ __forceinline__ float bf2f(unsigned short h) { return __uint_as_float((unsigned)h << 16); }
__device__ __forceinline__ float bflo(unsigned u) { return __uint_as_float(u << 16); }
__device__ __forceinline__ float bfhi(unsigned u) { return __uint_as_float(u & 0xffff0000u); }

template <class Fn> struct EpiB16 {
    static constexpr bool PERM = true, AFTER_DRAIN = false;
    bf16_t* O; int ldc; Fn fn;
    __device__ __forceinline__ void operator()(const f32x4 (&acc)[2][2][4][2], const Unit& u, int wr, int wc, int fr, int fq) const {
        const int row0 = u.pm * BM + wr * 64 + fr, col0 = u.pn * BM + wc * 32 + 8 * fq;
#pragma unroll
        for (int ai = 0; ai < 2; ++ai)
#pragma unroll
            for (int m = 0; m < 4; ++m) { const int row = row0 + ai * HALF + m * 16;
#pragma unroll
                for (int bj = 0; bj < 2; ++bj) { const int col = col0 + bj * HALF;
                    float v[8];
#pragma unroll
                    for (int j = 0; j < 4; ++j) { v[j] = acc[ai][bj][m][0][j]; v[4 + j] = acc[ai][bj][m][1][j]; }
                    fn(row, col, v);
                    u32x4 w; w.x = cvt_pk_bf16(v[0], v[1]); w.y = cvt_pk_bf16(v[2], v[3]); w.z = cvt_pk_bf16(v[4], v[5]); w.w = cvt_pk_bf16(v[6], v[7]);
                    *(u32x4*)(O + (size_t)row * ldc + col) = w; } }
    }
};
struct FnIn0 {
    const float* rope;
    __device__ __forceinline__ void operator()(int row, int col, float (&v)[8]) const {
        if (col < 640) {
            if (row < MLAT) {
                const int s = row & (SEQ - 1), p0 = (col & 63) >> 1, pos = p0 < 16 ? (s >> 6) : (s & 63), f0 = p0 & 15;
                const f32x4* t = (const f32x4*)(rope + (pos * 16 + f0) * 2);
                const f32x4 t0 = t[0], t1 = t[1];
                const float c[4] = {t0[0], t0[2], t1[0], t1[2]}, sn[4] = {t0[1], t0[3], t1[1], t1[3]};
#pragma unroll
                for (int i = 0; i < 4; ++i) { const float x1 = v[2 * i], x2 = v[2 * i + 1]; v[2 * i] = x1 * c[i] - x2 * sn[i]; v[2 * i + 1] = x1 * sn[i] + x2 * c[i]; }
            }
            if (col < 512) {
#pragma unroll
                for (int j = 0; j < 8; ++j) v[j] *= 0.125f;
            }
        } else if (col >= 768) {
#pragma unroll
            for (int j = 0; j < 8; ++j) v[j] = 0.5f * v[j] * (1.0f + erff(v[j] * 0.70710678118654752f));
        }
    }
};
struct FnIn1 {
    __device__ __forceinline__ void operator()(int, int col, float (&v)[8]) const {
        if (col < DM) {
#pragma unroll
            for (int j = 0; j < 8; ++j) v[j] *= 0.125f;
        }
    }
};
struct FnRelu2 {
    __device__ __forceinline__ void operator()(int, int, float (&v)[8]) const {
#pragma unroll
        for (int j = 0; j < 8; ++j) { const float r = fmaxf(v[j], 0.f); v[j] = r * r; }
    }
};
struct EpiRes {
    static constexpr bool PERM = false, AFTER_DRAIN = false;
    const float* res_lat; const float* res_ctx; float* out_lat; float* out_ctx; const float* gate;
    __device__ __forceinline__ void operator()(const f32x4 (&acc)[2][2][4][2], const Unit& u, int wr, int wc, int fr, int fq) const {
        const int row0 = u.pm * BM + wr * 64 + fr, col0 = u.pn * BM + wc * 32 + 4 * fq;
        const int mr = u.pm < (MLAT / BM) ? (u.pm >> 4) : NBATCH;
        const float* g = gate + (size_t)mr * MODW;
        f32x4 gv[2][2];
#pragma unroll
        for (int bj = 0; bj < 2; ++bj)
#pragma unroll
            for (int n = 0; n < 2; ++n) gv[bj][n] = *(const f32x4*)(g + col0 + bj * HALF + n * 16);
#pragma unroll
        for (int ai = 0; ai < 2; ++ai)
#pragma unroll
            for (int m = 0; m < 4; ++m) { const int row = row0 + ai * HALF + m * 16;
                const float* rp; float* op;
                if (row < MLAT) { rp = res_lat + (size_t)row * DM; op = out_lat + (size_t)row * DM; } else { rp = res_ctx + (size_t)(row - MLAT) * DM; op = out_ctx + (size_t)(row - MLAT) * DM; }
#pragma unroll
                for (int bj = 0; bj < 2; ++bj)
#pragma unroll
                    for (int n = 0; n < 2; ++n) { const int c = col0 + bj * HALF + n * 16; const f32x4 x = *(const f32x4*)(rp + c);
                        *(f32x4*)(op + c) = x * ALPHA + gv[bj][n] * acc[ai][bj][m][n]; }
                if (m & 1) asm volatile("" ::: "memory"); }
    }
};

template <class Epi, class Sched, bool ALIGN_EPI = false, bool SP2 = false>
__device__ __forceinline__ void gemm_phase(PG8_LAS unsigned char* lds, const Gemm g, const Sched& S, const Epi& E) {
    const int tid = threadIdx.x, wid = __builtin_amdgcn_readfirstlane(tid >> 6), lane = tid & 63, wr = wid >> 2, wc = wid & 3, fr = lane & 15, fq = lane >> 4;
    const int K = g.K, nt = K / BK;
    unsigned voffA[2], voffB[2];
#pragma unroll
    for (int i = 0; i < 2; ++i) { int R, C; stage_rc(tid * 16 + i * 8192, R, C); const int Rb = Epi::PERM ? ((R & ~31) + perm32(R & 31)) : R;
        voffA[i] = (unsigned)(R * K + C) * 2u; voffB[i] = (unsigned)(Rb * K + C) * 2u; }
    const size_t kstep = (size_t)(BK * 2);
    const size_t hstep = (size_t)HALF * K * 2;
    const size_t tstep = 2 * hstep;
    const unsigned ldsw = (unsigned)wid * 1024u;
    const int aoff = lds_byte(wr * 64 + fr, fq * 8), boff = lds_byte(wc * 32 + fr, fq * 8);
#define PG8_SA(b, h) (((b) * 2 + (h)) * HTB)
#define PG8_SB(b, h) ((4 + (b) * 2 + (h)) * HTB)
#define PG8_STAGE(bufoff, gbase, voff) do { _Pragma("unroll") for (int _i = 0; _i < 2; ++_i) \
        __builtin_amdgcn_global_load_lds((const unsigned*)((const char*)(gbase) + (voff)[_i]), (PG8_LAS unsigned*)(lds + (bufoff) + ldsw + _i * 8192), 16, 0, 0); } while (0)
#define PG8_LDA(dst, b, h) do { _Pragma("unroll") for (int m = 0; m < 4; ++m) _Pragma("unroll") for (int k = 0; k < 2; ++k) dst[m][k] = *(const PG8_LAS bf16x8*)(lds + PG8_SA(b, h) + aoff + m * 2048 + k * 1024); } while (0)
#define PG8_LDB(dst, b, h) do { _Pragma("unroll") for (int n = 0; n < 2; ++n) _Pragma("unroll") for (int k = 0; k < 2; ++k) dst[n][k] = *(const PG8_LAS bf16x8*)(lds + PG8_SB(b, h) + boff + n * 2048 + k * 1024); } while (0)
#define PG8_MMA(ai, bj, At, Bt) do { __builtin_amdgcn_s_setprio(1); _Pragma("unroll") for (int m = 0; m < 4; ++m) _Pragma("unroll") for (int n = 0; n < 2; ++n) _Pragma("unroll") for (int k = 0; k < 2; ++k) \
        acc[ai][bj][m][n] = __builtin_amdgcn_mfma_f32_16x16x32_bf16(Bt[n][k], At[m][k], acc[ai][bj][m][n], 0, 0, 0); __builtin_amdgcn_s_setprio(0); } while (0)
#define PG8_WAIT_V(n) asm volatile("s_waitcnt vmcnt(" #n ")" ::: "memory")
#define PG8_WAIT_L(n) asm volatile("s_waitcnt lgkmcnt(" #n ")" ::: "memory")
#define PG8_BAR __builtin_amdgcn_s_barrier()
#define PG8_SCHED __builtin_amdgcn_sched_barrier(0)
    Unit cur, nxt; int ui = 0;
    if (!S.next(0, cur)) return;
    f32x4 acc[2][2][4][2];
#pragma unroll
    for (int a = 0; a < 2; ++a)
#pragma unroll
        for (int b = 0; b < 2; ++b)
#pragma unroll
            for (int m = 0; m < 4; ++m)
#pragma unroll
                for (int n = 0; n < 2; ++n) acc[a][b][m][n] = (f32x4){0.f, 0.f, 0.f, 0.f};
    bf16x8 At[4][2], B0[2][2], B1[2][2];
    const char* cA = (const char*)g.A + (size_t)cur.pm * tstep; const char* cB = (const char*)g.Bt + (size_t)cur.pn * tstep;
    S.a_ready(cur);
    if constexpr (SP2) {
        PG8_STAGE(PG8_SB(0, 0), cB, voffB); PG8_STAGE(PG8_SB(0, 1), cB + hstep, voffB); PG8_STAGE(PG8_SA(0, 0), cA, voffA); PG8_STAGE(PG8_SA(0, 1), cA + hstep, voffA);
        if (wr == 1) PG8_BAR;
        PG8_WAIT_V(2); PG8_BAR;
        PG8_STAGE(PG8_SB(1, 0), cB + kstep, voffB); PG8_STAGE(PG8_SA(1, 0), cA + kstep, voffA); PG8_STAGE(PG8_SB(1, 1), cB + hstep + kstep, voffB);
        PG8_WAIT_V(6); PG8_BAR;
    } else {
        PG8_STAGE(PG8_SB(0, 0), cB, voffB); PG8_STAGE(PG8_SA(0, 0), cA, voffA); PG8_STAGE(PG8_SB(0, 1), cB + hstep, voffB); PG8_STAGE(PG8_SA(0, 1), cA + hstep, voffA);
        if (wr == 1) PG8_BAR;
        PG8_WAIT_V(4); PG8_BAR;
        PG8_STAGE(PG8_SB(1, 0), cB + kstep, voffB); PG8_STAGE(PG8_SA(1, 0), cA + kstep, voffA); PG8_STAGE(PG8_SB(1, 1), cB + hstep + kstep, voffB);
        PG8_WAIT_V(6); PG8_BAR;
    }
    for (;;) {
        const bool has_next = S.next(ui + 1, nxt);
        const char* nA = has_next ? (const char*)g.A + (size_t)nxt.pm * tstep : cA; const char* nB = has_next ? (const char*)g.Bt + (size_t)nxt.pn * tstep : cB;
        for (int t = 0; t < nt; t += 2) {
            const bool last = (t == nt - 2);
            const char* a1 = cA + (size_t)(t + 1) * kstep;
            const char* a2 = last ? nA : cA + (size_t)(t + 2) * kstep; const char* b2 = last ? nB : cB + (size_t)(t + 2) * kstep;
            const char* a3 = a2 + kstep; const char* b3 = b2 + kstep;
            if (last && has_next) S.a_ready(nxt);
            if constexpr (SP2) {
            PG8_LDB(B0, 0, 0); PG8_LDB(B1, 0, 1); PG8_SCHED; PG8_LDA(At, 0, 0); PG8_STAGE(PG8_SA(1, 1), a1 + hstep, voffA);
            PG8_WAIT_V(8); PG8_WAIT_L(0); PG8_BAR; PG8_MMA(0, 0, At, B0); PG8_MMA(0, 1, At, B1); PG8_BAR; PG8_SCHED;
            PG8_LDA(At, 0, 1); PG8_STAGE(PG8_SB(0, 0), b2, voffB); PG8_STAGE(PG8_SB(0, 1), b2 + hstep, voffB); PG8_STAGE(PG8_SA(0, 0), a2, voffA);
            PG8_WAIT_V(8); PG8_WAIT_L(0); PG8_BAR; PG8_MMA(1, 0, At, B0); PG8_MMA(1, 1, At, B1); PG8_BAR; PG8_SCHED;
            PG8_LDB(B0, 1, 0); PG8_LDB(B1, 1, 1); PG8_SCHED; PG8_LDA(At, 1, 0); PG8_STAGE(PG8_SA(0, 1), a2 + hstep, voffA);
            PG8_WAIT_V(8); PG8_WAIT_L(0); PG8_BAR; PG8_MMA(0, 0, At, B0); PG8_MMA(0, 1, At, B1); PG8_BAR; PG8_SCHED;
            PG8_LDA(At, 1, 1); PG8_STAGE(PG8_SB(1, 0), b3, voffB); PG8_STAGE(PG8_SB(1, 1), b3 + hstep, voffB); PG8_STAGE(PG8_SA(1, 0), a3, voffA);
            PG8_WAIT_V(8); PG8_WAIT_L(0); PG8_BAR; PG8_MMA(1, 0, At, B0); PG8_MMA(1, 1, At, B1); PG8_BAR; PG8_SCHED;
            } else {
            PG8_LDB(B0, 0, 0); PG8_SCHED; PG8_LDA(At, 0, 0); PG8_STAGE(PG8_SA(1, 1), a1 + hstep, voffA);
            PG8_WAIT_L(8); PG8_BAR; PG8_WAIT_L(0); PG8_MMA(0, 0, At, B0); PG8_BAR; PG8_SCHED;
            PG8_LDB(B1, 0, 1); PG8_STAGE(PG8_SB(0, 0), b2, voffB);
            PG8_BAR; PG8_WAIT_L(0); PG8_MMA(0, 1, At, B1); PG8_BAR;
            PG8_LDA(At, 0, 1); PG8_STAGE(PG8_SA(0, 0), a2, voffA);
            PG8_BAR; PG8_WAIT_L(0); PG8_MMA(1, 0, At, B0); PG8_BAR; PG8_SCHED;
            PG8_STAGE(PG8_SB(0, 1), b2 + hstep, voffB);
            PG8_WAIT_V(6); PG8_BAR; PG8_MMA(1, 1, At, B1); PG8_BAR;
            PG8_LDB(B0, 1, 0); PG8_SCHED; PG8_LDA(At, 1, 0); PG8_STAGE(PG8_SA(0, 1), a2 + hstep, voffA);
            PG8_WAIT_L(8); PG8_BAR; PG8_WAIT_L(0); PG8_MMA(0, 0, At, B0); PG8_BAR; PG8_SCHED;
            PG8_LDB(B1, 1, 1); PG8_STAGE(PG8_SB(1, 0), b3, voffB);
            PG8_BAR; PG8_WAIT_L(0); PG8_MMA(0, 1, At, B1); PG8_BAR;
            PG8_LDA(At, 1, 1); PG8_STAGE(PG8_SA(1, 0), a3, voffA);
            PG8_BAR; PG8_WAIT_L(0); PG8_MMA(1, 0, At, B0); PG8_BAR; PG8_SCHED;
            PG8_STAGE(PG8_SB(1, 1), b3 + hstep, voffB);
            PG8_WAIT_V(6); PG8_BAR; PG8_MMA(1, 1, At, B1); PG8_BAR;
            }
        }
        if constexpr (ALIGN_EPI) { if (wr == 0) PG8_BAR; }
        if constexpr (!Epi::AFTER_DRAIN) { E(acc, cur, wr, wc, fr, fq); S.done(cur); }
        if (!has_next) break;
#pragma unroll
        for (int a = 0; a < 2; ++a)
#pragma unroll
            for (int b = 0; b < 2; ++b)
#pragma unroll
                for (int m = 0; m < 4; ++m)
#pragma unroll
                    for (int n = 0; n < 2; ++n) acc[a][b][m][n] = (f32x4){0.f, 0.f, 0.f, 0.f};
        cur = nxt; cA = nA; cB = nB; ++ui;
        if constexpr (ALIGN_EPI) { if (wr == 1) PG8_BAR; }
    }
    PG8_WAIT_V(0);
    if constexpr (!ALIGN_EPI) { if (wr == 0) PG8_BAR; }
    PG8_BAR;
    if constexpr (Epi::AFTER_DRAIN) { E.fused(acc, cur, wr, wc, fr, fq, lds, wid, lane); S.done(cur); }
#undef PG8_SA
#undef PG8_SB
#undef PG8_STAGE
#undef PG8_LDA
#undef PG8_LDB
#undef PG8_MMA
#undef PG8_WAIT_V
#undef PG8_WAIT_L
#undef PG8_BAR
#undef PG8_SCHED
}
}

#ifndef MK_N_LAUNCHES
#define MK_N_LAUNCHES 1
#endif
constexpr int NPH = 16;
constexpr int NWAVES = 8, NTHR = NWAVES * 64;
constexpr int LDS_BYTES = 147456;
#define LAS __attribute__((address_space(3)))
typedef unsigned short bf16;
typedef float f32x4 __attribute__((ext_vector_type(4)));
typedef unsigned v4u __attribute__((ext_vector_type(4)));
typedef unsigned v2u __attribute__((ext_vector_type(2)));
using pg8::bf2f; using pg8::bflo; using pg8::bfhi; using pg8::cvt_pk_bf16;

constexpr size_t MiB = 1u << 20;
constexpr size_t WS_CTL = 0, CTL_ZERO_BYTES = 1 * MiB;
constexpr size_t WS_MOD = 1 * MiB;
constexpr size_t WS_ROPE = 1 * MiB + 512 * 1024;
constexpr size_t WS_WABIN = 2 * MiB, WS_WABOUT = 6 * MiB, WS_WCIN = 8 * MiB, WS_WCOUT = 14 * MiB, WS_W1 = 16 * MiB, WS_W2 = 32 * MiB;
constexpr size_t WS_XRC = 48 * MiB;
constexpr size_t WS_ACT = 56 * MiB;
constexpr size_t WS_BIG = 128 * MiB;
constexpr size_t WS_END = 400 * MiB;
static_assert(WS_ACT + (size_t)MALL * DM * 2 <= WS_BIG && WS_BIG + (size_t)MALL * FF * 2 <= WS_END, "d_ws map");

struct Args { const float* in[22]; float* out; unsigned char* ws; float freq[16]; int ph_lo, ph_hi; };
enum { I_X = 0, I_C, I_CTX, I_CCTX, I_WMOD, I_BMOD, I_ABWIN, I_SINK, I_BLNG, I_BLNB, I_BWS, I_BBS, I_ABWOUT, I_CWIN, I_RPB, I_CWOUT, I_LN1G, I_LN1B, I_W1, I_W2, I_LN2G, I_LN2B };

__device__ __forceinline__ float wave_sum(float v) {
#pragma unroll
    for (int o = 1; o < 64; o <<= 1) v += __shfl_xor(v, o);
    return v;
}
__device__ __forceinline__ unsigned f2bf(float f) { unsigned u = __builtin_bit_cast(unsigned, f); return (u + 0x7fffu + ((u >> 16) & 1u)) >> 16; }
__device__ __forceinline__ unsigned pk2(float lo, float hi) { return f2bf(lo) | (f2bf(hi) << 16); }

__device__ __forceinline__ void sincos_d(double x, double& s, double& c) {
    const double kd = rint(x * 0.63661977236758134308); const int k = (int)kd;
    const double r = (x - kd * 1.57079632679489655800) - kd * 6.12323399573676603587e-17, r2 = r * r;
    const double sp = r * (1.0 + r2 * (-1.0 / 6.0 + r2 * (1.0 / 120.0 + r2 * (-1.0 / 5040.0 + r2 * (1.0 / 362880.0 + r2 * (-1.0 / 39916800.0 + r2 * (1.0 / 6227020800.0 + r2 * (-1.0 / 1307674368000.0))))))));
    const double cp = 1.0 + r2 * (-0.5 + r2 * (1.0 / 24.0 + r2 * (-1.0 / 720.0 + r2 * (1.0 / 40320.0 + r2 * (-1.0 / 3628800.0 + r2 * (1.0 / 479001600.0 + r2 * (-1.0 / 87178291200.0 + r2 * (1.0 / 20922789888000.0))))))));
    const int q = k & 3;
    s = q == 0 ? sp : q == 1 ? cp : q == 2 ? -sp : -cp;
    c = q == 0 ? cp : q == 1 ? -sp : q == 2 ? -cp : sp;
}

__device__ __forceinline__ void p0_transpose_item(const float* W, int K, int N, bf16* WT, LAS float* scr, int item, int lane) {
    const int nblk = N / 32, kb = item / nblk, nb = item % nblk, k0 = 64 * kb, n0 = 32 * nb;
#pragma unroll 8
    for (int i = 0; i < 32; ++i) { const int kk = 2 * i + (lane >> 5); scr[kk * 33 + (lane & 31)] = W[(size_t)(k0 + kk) * N + n0 + (lane & 31)]; }
    asm volatile("s_waitcnt lgkmcnt(0)" ::: "memory");
    const int c = lane & 7;
#pragma unroll
    for (int j = 0; j < 4; ++j) { const int n = (lane >> 3) + 8 * j; const LAS float* s = scr + (8 * c) * 33 + n;
        v4u o; o.x = pk2(s[0 * 33], s[1 * 33]); o.y = pk2(s[2 * 33], s[3 * 33]); o.z = pk2(s[4 * 33], s[5 * 33]); o.w = pk2(s[6 * 33], s[7 * 33]);
        *(v4u*)(WT + (size_t)(n0 + n) * K + k0 + 8 * c) = o; }
    asm volatile("s_waitcnt lgkmcnt(0)" ::: "memory");
}

__device__ __forceinline__ void p0_mod_item(const Args& a, LAS unsigned char* lds, int item, int tid, int lane, int wave) {
    LAS float* sc = (LAS float*)lds;
    LAS float* red = sc + 9 * DM;
    const int l = item / 96, strip = item % 96;
    const float* c = a.in[I_C]; const float* cc = a.in[I_CCTX];
    for (int i = tid; i < 9 * DM; i += NTHR) { const int r = i >> 10, k = i & (DM - 1); const float v = r < NBATCH ? c[r * DM + k] : cc[k]; sc[i] = v / (1.0f + expf(-v)); }
    __syncthreads();
    const float* w = a.in[I_WMOD] + (size_t)l * DM * MODW + strip * 64 + lane;
    float acc[9];
#pragma unroll
    for (int r = 0; r < 9; ++r) acc[r] = 0.f;
    const int k0 = wave * 128;
#pragma unroll 4
    for (int k = k0; k < k0 + 128; ++k) { const float wv = w[(size_t)k * MODW];
#pragma unroll
        for (int r = 0; r < 9; ++r) acc[r] = fmaf(sc[r * DM + k], wv, acc[r]); }
#pragma unroll
    for (int r = 0; r < 9; ++r) red[(wave * 9 + r) * 64 + lane] = acc[r];
    __syncthreads();
    float* mod = (float*)(a.ws + WS_MOD);
    for (int i = tid; i < 9 * 64; i += NTHR) { const int r = i >> 6, ln = i & 63; float s = 0.f;
#pragma unroll
        for (int wv = 0; wv < 8; ++wv) s += red[(wv * 9 + r) * 64 + ln];
        const int n = strip * 64 + ln; mod[(size_t)(l * 9 + r) * MODW + n] = s + a.in[I_BMOD][l * MODW + n]; }
    __syncthreads();
}

__device__ __forceinline__ void ph0_prologue(const Args& a, LAS unsigned char* lds, int tid, int lane, int wave, int bid, int G) {
    if (bid == G - 1) {
        float* rope = (float*)(a.ws + WS_ROPE);
        for (int i = tid; i < 64 * 16; i += NTHR) { const int pos = i >> 4, f = i & 15; const float ang = (float)pos * a.freq[f]; double s, c; sincos_d((double)ang, s, c); rope[2 * i] = (float)c; rope[2 * i + 1] = (float)s; }
    }
    for (int item = bid; item < 192; item += G) p0_mod_item(a, lds, item, tid, lane, wave);
    LAS float* scr = (LAS float*)(lds + wave * 16384);
    const int gw = bid * NWAVES + wave, NGW = G * NWAVES;
    constexpr int I_A = (DM / 64) * (ABIN / 32), I_O = (DM / 64) * (DM / 32), I_CI = (DM / 64) * (CIN / 32), I_U = (DM / 64) * (FF / 32), I_D = (FF / 64) * (DM / 32);
    constexpr int NITEMS = I_A + I_O + I_CI + I_O + 2 * I_U + 2 * I_D;
    unsigned char* ws = a.ws;
    for (int it = gw; it < NITEMS; it += NGW) {
        int r = it;
        if (r < I_A) { p0_transpose_item(a.in[I_ABWIN], DM, ABIN, (bf16*)(ws + WS_WABIN), scr, r, lane); continue; } r -= I_A;
        if (r < I_O) { p0_transpose_item(a.in[I_ABWOUT], DM, DM, (bf16*)(ws + WS_WABOUT), scr, r, lane); continue; } r -= I_O;
        if (r < I_CI) { p0_transpose_item(a.in[I_CWIN], DM, CIN, (bf16*)(ws + WS_WCIN), scr, r, lane); continue; } r -= I_CI;
        if (r < I_O) { p0_transpose_item(a.in[I_CWOUT], DM, DM, (bf16*)(ws + WS_WCOUT), scr, r, lane); continue; } r -= I_O;
        if (r < 2 * I_U) { const int l = r / I_U; p0_transpose_item(a.in[I_W1] + (size_t)l * DM * FF, DM, FF, (bf16*)(ws + WS_W1 + (size_t)l * 8 * MiB), scr, r % I_U, lane); continue; } r -= 2 * I_U;
        { const int l = r / I_D; p0_transpose_item(a.in[I_W2] + (size_t)l * DM * FF, FF, DM, (bf16*)(ws + WS_W2 + (size_t)l * 8 * MiB), scr, r % I_D, lane); }
    }
}

__device__ __forceinline__ float* xr_row(const Args& a, int row) { return row < MLAT ? a.out + (size_t)row * DM : (float*)(a.ws + WS_XRC) + (size_t)(row - MLAT) * DM; }
__device__ __forceinline__ int mod_row(int row) { return row < MLAT ? (row >> 12) : NBATCH; }

__device__ __forceinline__ void ph1_modulate(const Args& a, int lane, int gw, int NGW) {
    const float* mod0 = (const float*)(a.ws + WS_MOD);
    bf16* act = (bf16*)(a.ws + WS_ACT);
    for (int row = gw; row < MALL; row += NGW) {
        const float* src = row < MLAT ? a.in[I_X] + (size_t)row * DM : a.in[I_CTX] + (size_t)(row - MLAT) * DM;
        const float* mr = mod0 + (size_t)mod_row(row) * MODW;
#pragma unroll
        for (int j = 0; j < 4; ++j) { const int c = 4 * lane + 256 * j; const f32x4 v = *(const f32x4*)(src + c), sh = *(const f32x4*)(mr + c), sc = *(const f32x4*)(mr + DM + c);
            const f32x4 h = v * (sc + 1.0f) + sh; v2u o; o.x = pk2(h[0], h[1]); o.y = pk2(h[2], h[3]); *(v2u*)(act + (size_t)row * DM + c) = o; }
    }
}

__device__ __forceinline__ void ph_layernorm(const Args& a, int nrows, const float* gam, const float* bet, const float* modv, int lane, int gw, int NGW) {
    bf16* act = (bf16*)(a.ws + WS_ACT);
    for (int row = gw; row < nrows; row += NGW) {
        float* xr = xr_row(a, row);
        f32x4 v[4]; float s = 0.f;
#pragma unroll
        for (int j = 0; j < 4; ++j) { v[j] = *(const f32x4*)(xr + 4 * lane + 256 * j); s += (v[j][0] + v[j][1]) + (v[j][2] + v[j][3]); }
        const float mean = wave_sum(s) * (1.0f / DM); float s2 = 0.f;
#pragma unroll
        for (int j = 0; j < 4; ++j) { v[j] = v[j] - mean; s2 += (v[j][0] * v[j][0] + v[j][1] * v[j][1]) + (v[j][2] * v[j][2] + v[j][3] * v[j][3]); }
        const float rstd = 1.0f / sqrtf(wave_sum(s2) * (1.0f / DM) + LN_EPS);
#pragma unroll
        for (int j = 0; j < 4; ++j) { const int c = 4 * lane + 256 * j; const f32x4 y = v[j] * rstd * *(const f32x4*)(gam + c) + *(const f32x4*)(bet + c);
            *(f32x4*)(xr + c) = y;
            if (modv) { const float* mr = modv + (size_t)mod_row(row) * MODW; const f32x4 h = y * (*(const f32x4*)(mr + DM + c) + 1.0f) + *(const f32x4*)(mr + c);
                v2u o; o.x = pk2(h[0], h[1]); o.y = pk2(h[2], h[3]); *(v2u*)(act + (size_t)row * DM + c) = o; } }
    }
}

__device__ __forceinline__ void attn_key(const bf16* kp, const bf16* vp, bool valid, float bias, const float (&q)[64], float (&o)[64], float& m, float& l) {
    float dot = 0.f;
#pragma unroll
    for (int c = 0; c < 8; ++c) { const v4u kk = ((const v4u*)kp)[c];
        dot = fmaf(q[8 * c + 0], bflo(kk.x), dot); dot = fmaf(q[8 * c + 1], bfhi(kk.x), dot); dot = fmaf(q[8 * c + 2], bflo(kk.y), dot); dot = fmaf(q[8 * c + 3], bfhi(kk.y), dot);
        dot = fmaf(q[8 * c + 4], bflo(kk.z), dot); dot = fmaf(q[8 * c + 5], bfhi(kk.z), dot); dot = fmaf(q[8 * c + 6], bflo(kk.w), dot); dot = fmaf(q[8 * c + 7], bfhi(kk.w), dot); }
    const float sc = valid ? dot + bias : -1e30f;
    const float mn = fmaxf(m, sc), corr = __expf(m - mn), p = __expf(sc - mn);
    l = l * corr + p; m = mn;
#pragma unroll
    for (int c = 0; c < 8; ++c) { const v4u vv = ((const v4u*)vp)[c];
        o[8 * c + 0] = fmaf(o[8 * c + 0], corr, p * bflo(vv.x)); o[8 * c + 1] = fmaf(o[8 * c + 1], corr, p * bfhi(vv.x)); o[8 * c + 2] = fmaf(o[8 * c + 2], corr, p * bflo(vv.y)); o[8 * c + 3] = fmaf(o[8 * c + 3], corr, p * bfhi(vv.y));
        o[8 * c + 4] = fmaf(o[8 * c + 4], corr, p * bflo(vv.z)); o[8 * c + 5] = fmaf(o[8 * c + 5], corr, p * bfhi(vv.z)); o[8 * c + 6] = fmaf(o[8 * c + 6], corr, p * bflo(vv.w)); o[8 * c + 7] = fmaf(o[8 * c + 7], corr, p * bfhi(vv.w)); }
}
__device__ __forceinline__ void load_q64(const bf16* qp, float (&q)[64]) {
#pragma unroll
    for (int c = 0; c < 8; ++c) { const v4u t = ((const v4u*)qp)[c]; q[8 * c + 0] = bflo(t.x); q[8 * c + 1] = bfhi(t.x); q[8 * c + 2] = bflo(t.y); q[8 * c + 3] = bfhi(t.y); q[8 * c + 4] = bflo(t.z); q[8 * c + 5] = bfhi(t.z); q[8 * c + 6] = bflo(t.w); q[8 * c + 7] = bfhi(t.w); }
}
__device__ __forceinline__ void store_o64(bf16* op, const float (&o)[64], float inv) {
#pragma unroll
    for (int c = 0; c < 8; ++c) { v4u w; w.x = pk2(o[8 * c + 0] * inv, o[8 * c + 1] * inv); w.y = pk2(o[8 * c + 2] * inv, o[8 * c + 3] * inv); w.z = pk2(o[8 * c + 4] * inv, o[8 * c + 5] * inv); w.w = pk2(o[8 * c + 6] * inv, o[8 * c + 7] * inv); ((v4u*)op)[c] = w; }
}
__device__ __forceinline__ void l0_attn_item_naive(const Args& a, int item, int lane, int wave) {
    const bf16* Z = (const bf16*)(a.ws + WS_BIG); bf16* AB = (bf16*)(a.ws + WS_ACT);
    const int row = item * 64 + lane, h = wave, hkv = h >> 2;
    const bool latent = item < MLAT / 64;
    const int b = latent ? item >> 6 : (item - MLAT / 64) >> 2;
    float q[64], o[64];
    load_q64(Z + (size_t)row * ABIN + 64 * h, q);
#pragma unroll
    for (int d = 0; d < 64; ++d) o[d] = 0.f;
    float m = a.in[I_SINK][h], l = 1.0f;
    const bf16* kc = Z + (size_t)(MLAT + b * CTXL) * ABIN + 512 + 64 * hkv;
    for (int j = 0; j < CTXL; ++j) attn_key(kc + (size_t)j * ABIN, kc + (size_t)j * ABIN + 128, true, 0.f, q, o, m, l);
    if (latent) {
        const int s0 = (item & 63) * 64, s = s0 + lane, lo = s0 - 128 < 0 ? 0 : s0 - 128, hi = s0 + 191 > SEQ - 1 ? SEQ - 1 : s0 + 191;
        const bf16* kl = Z + (size_t)(b * SEQ) * ABIN + 512 + 64 * hkv;
        for (int kp = lo; kp <= hi; ++kp) { const int d = s - kp; attn_key(kl + (size_t)kp * ABIN, kl + (size_t)kp * ABIN + 128, d <= 128 && d >= -128, 0.f, q, o, m, l); }
    }
    store_o64(AB + (size_t)row * DM + 64 * h, o, 1.0f / l);
}
__device__ __forceinline__ void l0_gate_chunk_naive(const Args& a, LAS unsigned char* lds, int chunk, int tid, int lane, int wave) {
    const bf16* Z = (const bf16*)(a.ws + WS_BIG); bf16* AB = (bf16*)(a.ws + WS_ACT);
    LAS float* st = (LAS float*)lds;
    LAS float* vn = st + 256;
    const int base = chunk * 128;
    for (int i = 0; i < 16; ++i) { const int r = wave * 16 + i; const v4u t = *(const v4u*)(Z + (size_t)(base + r) * ABIN + 1280 + lane * 8);
        float x[8] = {bflo(t.x), bfhi(t.x), bflo(t.y), bfhi(t.y), bflo(t.z), bfhi(t.z), bflo(t.w), bfhi(t.w)}; float s = 0.f;
#pragma unroll
        for (int j = 0; j < 8; ++j) s += x[j];
        const float mean = wave_sum(s) * (1.0f / 512.0f); float s2 = 0.f;
#pragma unroll
        for (int j = 0; j < 8; ++j) { const float d = x[j] - mean; s2 += d * d; }
        const float var = wave_sum(s2) * (1.0f / 512.0f);
        if (lane == 0) { st[2 * r] = mean; st[2 * r + 1] = 1.0f / sqrtf(var + LN_EPS); } }
    __syncthreads();
    const float* wsg = a.in[I_BWS]; const float* bs = a.in[I_BBS];
    for (int g = 0; g < 8; ++g) {
        { const int c = tid & 63; const float lg = a.in[I_BLNG][g * 64 + c], lb = a.in[I_BLNB][g * 64 + c];
          for (int i = 0; i < 16; ++i) { const int qq = (tid >> 6) + 8 * i; const float x = bf2f(Z[(size_t)(base + qq) * ABIN + 1280 + g * 64 + c]); vn[qq * 64 + c] = (x - st[2 * qq]) * st[2 * qq + 1] * lg + lb; } }
        __syncthreads();
        float acc[16];
#pragma unroll
        for (int j = 0; j < 16; ++j) acc[j] = 0.f;
        const float* wrow = wsg + (size_t)(g * 128 + wave * 16) * 128;
        for (int qq = 0; qq < 128; ++qq) { const float v = vn[qq * 64 + lane];
#pragma unroll
            for (int j = 0; j < 16; ++j) acc[j] = fmaf(wrow[j * 128 + qq], v, acc[j]); }
#pragma unroll
        for (int j = 0; j < 16; ++j) { const int p = wave * 16 + j; const size_t row = (size_t)(base + p); const float mixed = acc[j] + bs[g * 128 + p]; const float u = bf2f(Z[row * ABIN + 768 + g * 64 + lane]);
            AB[row * DM + 512 + g * 64 + lane] = (bf16)f2bf(u * mixed); }
        __syncthreads();
    }
}
__device__ __forceinline__ void l1_natten_item_naive(const Args& a, int item, int lane, int wave) {
    const bf16* Z = (const bf16*)(a.ws + WS_BIG); bf16* AC = (bf16*)(a.ws + WS_ACT);
    const int rg = item >> 1, h = (item & 1) * 8 + wave, row = rg * 64 + lane, b = rg >> 6, r = rg & 63, c = lane;
    const int r0 = r - 4 < 0 ? 0 : (r - 4 > 56 ? 56 : r - 4), qs = c - 8 < 0 ? 0 : (c - 8 > 48 ? 48 : c - 8);
    float q[64], o[64];
    load_q64(Z + (size_t)row * CIN + 64 * h, q);
#pragma unroll
    for (int d = 0; d < 64; ++d) o[d] = 0.f;
    float m = -1e30f, l = 0.f;
    const bf16* kc = Z + (size_t)(MLAT + b * CTXL) * CIN + DM + 64 * h;
    for (int j = 0; j < CTXL; ++j) attn_key(kc + (size_t)j * CIN, kc + (size_t)j * CIN + DM, true, 0.f, q, o, m, l);
    const float* rpb = a.in[I_RPB] + h * 465;
    for (int kr = r0; kr < r0 + 8; ++kr) {
        const bf16* kl = Z + (size_t)(b * SEQ + kr * 64) * CIN + DM + 64 * h; const float* brow = rpb + (kr - r + 7) * 31;
        for (int kcx = 0; kcx < 64; ++kcx) { int dc = kcx - c + 15; dc = dc < 0 ? 0 : (dc > 30 ? 30 : dc);
            attn_key(kl + (size_t)kcx * CIN, kl + (size_t)kcx * CIN + DM, kcx >= qs && kcx < qs + 16, brow[dc], q, o, m, l); }
    }
    store_o64(AC + (size_t)row * DM + 64 * h, o, 1.0f / l);
}

__global__ void __launch_bounds__(NTHR, 2) mk_fwd(Args a) {
    extern __shared__ __attribute__((aligned(16))) unsigned char lds_raw[];
    LAS unsigned char* lds = (LAS unsigned char*)lds_raw;
    const int tid = threadIdx.x, lane = tid & 63, wave = __builtin_amdgcn_readfirstlane(tid >> 6);
    const int bid = blockIdx.x, G = gridDim.x;
    const int gw = bid * NWAVES + wave, NGW = G * NWAVES;
    const int lo = a.ph_lo, hi = a.ph_hi;
    unsigned char* ws = a.ws;
    const float* mod0 = (const float*)(ws + WS_MOD);
    const float* mod1 = mod0 + 9 * MODW;
    bf16* ACT = (bf16*)(ws + WS_ACT); bf16* BIG = (bf16*)(ws + WS_BIG);
    float* XRC = (float*)(ws + WS_XRC);
#define IN(k) (lo <= (k) && (k) < hi)
#define SEAM(k) do { if (IN(k) && IN((k) + 1)) { cg::this_grid().sync(); } } while (0)
#define GEMM_PHASE(EPI, Ap, Btp, M_, N_, K_, E) do { const pg8::Gemm g_{(const pg8::bf16_t*)(Ap), (const pg8::bf16_t*)(Btp), (M_), (N_), (K_)}; pg8::StaticOrder S_; S_.init((M_), (N_), G, bid); \
        pg8::gemm_phase<EPI, pg8::StaticOrder, true, true>(lds, g_, S_, (E)); } while (0)

    if (IN(0)) { ph0_prologue(a, lds, tid, lane, wave, bid, G); } SEAM(0);
    if (IN(1)) { ph1_modulate(a, lane, gw, NGW); } SEAM(1);
    if (IN(2)) { const pg8::EpiB16<pg8::FnIn0> E{BIG, ABIN, pg8::FnIn0{(const float*)(ws + WS_ROPE)}}; GEMM_PHASE(pg8::EpiB16<pg8::FnIn0>, ACT, ws + WS_WABIN, MALL, ABIN, DM, E); } SEAM(2);
    if (IN(3)) {
        for (int it = bid; it < MALL / 64 + MALL / 128; it += G) { if (it < MALL / 64) l0_attn_item_naive(a, it, lane, wave); else l0_gate_chunk_naive(a, lds, it - MALL / 64, tid, lane, wave); }
    } SEAM(3);
    if (IN(4)) { const pg8::EpiRes E{a.in[I_X], a.in[I_CTX], a.out, XRC, mod0 + 2 * DM}; GEMM_PHASE(pg8::EpiRes, ACT, ws + WS_WABOUT, MALL, DM, DM, E); } SEAM(4);
    if (IN(5)) { ph_layernorm(a, MALL, a.in[I_LN1G], a.in[I_LN1B], mod0 + 3 * DM, lane, gw, NGW); } SEAM(5);
    if (IN(6)) { const pg8::EpiB16<pg8::FnRelu2> E{BIG, FF, pg8::FnRelu2{}}; GEMM_PHASE(pg8::EpiB16<pg8::FnRelu2>, ACT, ws + WS_W1, MALL, FF, DM, E); } SEAM(6);
    if (IN(7)) { const pg8::EpiRes E{a.out, XRC, a.out, XRC, mod0 + 5 * DM}; GEMM_PHASE(pg8::EpiRes, BIG, ws + WS_W2, MALL, DM, FF, E); } SEAM(7);
    if (IN(8)) { ph_layernorm(a, MALL, a.in[I_LN2G], a.in[I_LN2B], mod1, lane, gw, NGW); } SEAM(8);
    if (IN(9)) { const pg8::EpiB16<pg8::FnIn1> E{BIG, CIN, pg8::FnIn1{}}; GEMM_PHASE(pg8::EpiB16<pg8::FnIn1>, ACT, ws + WS_WCIN, MALL, CIN, DM, E); } SEAM(9);
    if (IN(10)) { for (int it = bid; it < (MLAT / 64) * 2; it += G) l1_natten_item_naive(a, it, lane, wave); } SEAM(10);
    if (IN(11)) { const pg8::EpiRes E{a.out, XRC, a.out, XRC, mod1 + 2 * DM}; GEMM_PHASE(pg8::EpiRes, ACT, ws + WS_WCOUT, MLAT, DM, DM, E); } SEAM(11);
    if (IN(12)) { ph_layernorm(a, MLAT, a.in[I_LN1G] + DM, a.in[I_LN1B] + DM, mod1 + 3 * DM, lane, gw, NGW); } SEAM(12);
    if (IN(13)) { const pg8::EpiB16<pg8::FnRelu2> E{BIG, FF, pg8::FnRelu2{}}; GEMM_PHASE(pg8::EpiB16<pg8::FnRelu2>, ACT, ws + WS_W1 + 8 * MiB, MLAT, FF, DM, E); } SEAM(13);
    if (IN(14)) { const pg8::EpiRes E{a.out, XRC, a.out, XRC, mod1 + 5 * DM}; GEMM_PHASE(pg8::EpiRes, BIG, ws + WS_W2 + 8 * MiB, MLAT, DM, FF, E); } SEAM(14);
    if (IN(15)) { ph_layernorm(a, MLAT, a.in[I_LN2G] + DM, a.in[I_LN2B] + DM, nullptr, lane, gw, NGW); }
#undef IN
#undef SEAM
#undef GEMM_PHASE
}

extern "C" void kernel_launch(void* const* d_in, const int* in_sizes, int n_in, void* d_out, int out_size, void* d_ws, size_t ws_size, hipStream_t stream) {
    static int grid = 0;
    if (grid == 0) {
        if (n_in != 22 || in_sizes[0] != MLAT * DM || out_size != MLAT * DM || ws_size < WS_END) { fprintf(stderr, "kernel_launch: unexpected shapes (n_in %d, in0 %d, out %d, ws %zu)\n", n_in, n_in > 0 ? in_sizes[0] : -1, out_size, ws_size); grid = -1; return; }
        int dev = 0, cus = 0, per_cu = 0;
        if (hipGetDevice(&dev) != hipSuccess || hipDeviceGetAttribute(&cus, hipDeviceAttributeMultiprocessorCount, dev) != hipSuccess) { grid = -1; return; }
        if (hipFuncSetAttribute((const void*)mk_fwd, hipFuncAttributeMaxDynamicSharedMemorySize, LDS_BYTES) != hipSuccess) { fprintf(stderr, "kernel_launch: hipFuncSetAttribute failed\n"); grid = -1; return; }
        if (hipOccupancyMaxActiveBlocksPerMultiprocessor(&per_cu, (const void*)mk_fwd, NTHR, LDS_BYTES) != hipSuccess || per_cu < 1) { fprintf(stderr, "kernel_launch: occupancy query says %d blocks per CU\n", per_cu); per_cu = 1; }
        (void)hipGetLastError();
        grid = cus * (per_cu < 1 ? 1 : per_cu);
    }
    if (grid < 0) return;
    Args a{};
    for (int i = 0; i < 22; ++i) a.in[i] = (const float*)d_in[i];
    a.out = (float*)d_out; a.ws = (unsigned char*)d_ws;
    for (int i = 0; i < 16; ++i) a.freq[i] = powf(10000.0f, -(float)i / 16.0f);
    if (MK_N_LAUNCHES == 1) {
        a.ph_lo = 0; a.ph_hi = NPH;
        void* args[] = {&a};
        const hipError_t e = hipLaunchCooperativeKernel((const void*)mk_fwd, dim3(grid), dim3(NTHR), args, LDS_BYTES, stream);
        if (e != hipSuccess) fprintf(stderr, "kernel_launch: cooperative launch failed: %s (grid %d)\n", hipGetErrorString(e), grid);
    } else {
        for (int p = 0; p < NPH; ++p) { a.ph_lo = p; a.ph_hi = p + 1; hipLaunchKernelGGL(mk_fwd, dim3(grid), dim3(NTHR), LDS_BYTES, stream, a); }
    }
}
```

```cpp
#include <hip/hip_runtime.h>
#include <hip/hip_cooperative_groups.h>
#include <cstdio>
#include <cstdint>
namespace cg = cooperative_groups;

constexpr int DM = 1024, NBATCH = 8, SEQ = 4096, CTXL = 256;
constexpr int MLAT = NBATCH * SEQ;
constexpr int MCTX = NBATCH * CTXL;
constexpr int MALL = MLAT + MCTX;
constexpr int ABIN = 1792, CIN = 3072, FF = 4096, MODW = 6 * DM;
constexpr float LN_EPS = 1e-5f, ALPHA = 1.41421356237309515f;
namespace pg8 {
#define PG8_LAS __attribute__((address_space(3)))
typedef unsigned short bf16_t;
typedef short bf16x8 __attribute__((ext_vector_type(8)));
typedef float f32x4 __attribute__((ext_vector_type(4)));
typedef unsigned u32x4 __attribute__((ext_vector_type(4)));
constexpr int BM = 256, BK = 64, HALF = 128, HTB = HALF * BK * 2  , STAGE_BYTES = 8 * HTB, NXCD = 8, WGM = 8;

__host__ __device__ __forceinline__ int lds_byte(int r, int c) { const int st = (r >> 4) * 2 + (c >> 5), rr = r & 15, cc = c & 31, ob = rr * 64 + cc * 2; return st * 1024 + (ob ^ (((ob >> 9) & 1) << 5)); }
__host__ __device__ __forceinline__ void stage_rc(int b, int& R, int& C) { const int st = b / 1024, sb = b % 1024, swz = sb ^ (((sb >> 9) & 1) << 5); R = (st >> 1) * 16 + swz / 64; C = (st & 1) * 32 + (swz % 64) / 2; }
__host__ __device__ __forceinline__ int perm32(int rho) { const int n = rho >> 4, i = rho & 15; return 8 * (i >> 2) + 4 * n + (i & 3); }

struct Unit { int pm, pn; };
struct Gemm { const bf16_t* A; const bf16_t* Bt; int M, N, K; };

struct StaticOrder {
    int nM, nN, nwg, G, c;
    __host__ __device__ void init(int M, int N, int G_, int c_) { nM = M / BM; nN = N / BM; nwg = nM * nN; G = G_; c = c_; }
    __host__ __device__ bool next(int i, Unit& u) const {
        const long L = (long)i * G + c; if (L >= nwg) return false;
        int wgid = (int)L; { const int q = nwg / NXCD, r = nwg % NXCD, xcd = wgid % NXCD, off = wgid / NXCD; wgid = (xcd < r ? xcd * (q + 1) : r * (q + 1) + (xcd - r) * q) + off; }
        const int nig = WGM * nN, gid = wgid / nig, fm = gid * WGM, gsz = (nM - fm) < WGM ? (nM - fm) : WGM;
        u.pm = fm + ((wgid % nig) % gsz); u.pn = (wgid % nig) / gsz; return true;
    }
    __device__ __forceinline__ void a_ready(const Unit&) const {}
    __device__ __forceinline__ void done(const Unit&) const {}
};

__device__ __forceinline__ unsigned cvt_pk_bf16(float lo, float hi) { unsigned r; asm volatile("v_cvt_pk_bf16_f32 %0, %1, %2" : "=v"(r) : "v"(lo), "v"(hi)); return r; }
typedef float f32x2 __attribute__((ext_vector_type(2)));
__device__ __forceinline__ float bf2f(unsigned short h) { return __uint_as_float((unsigned)h << 16); }
__device__ __forceinline__ float bflo(unsigned u) { return __uint_as_float(u << 16); }
__device__ __forceinline__ float bfhi(unsigned u) { return __uint_as_float(u & 0xffff0000u); }

template <class Fn> struct EpiB16 {
    static constexpr bool PERM = true, AFTER_DRAIN = false;
    bf16_t* O; int ldc; Fn fn;
    __device__ __forceinline__ void operator()(const f32x4 (&acc)[2][2][4][2], const Unit& u, int wr, int wc, int fr, int fq) const {
        const int row0 = u.pm * BM + wr * 64 + fr, col0 = u.pn * BM + wc * 32 + 8 * fq;
#pragma unroll
        for (int ai = 0; ai < 2; ++ai)
#pragma unroll
            for (int m = 0; m < 4; ++m) { const int row = row0 + ai * HALF + m * 16;
#pragma unroll
                for (int bj = 0; bj < 2; ++bj) { const int col = col0 + bj * HALF;
                    float v[8];
#pragma unroll
                    for (int j = 0; j < 4; ++j) { v[j] = acc[ai][bj][m][0][j]; v[4 + j] = acc[ai][bj][m][1][j]; }
                    fn(row, col, v);
                    u32x4 w; w.x = cvt_pk_bf16(v[0], v[1]); w.y = cvt_pk_bf16(v[2], v[3]); w.z = cvt_pk_bf16(v[4], v[5]); w.w = cvt_pk_bf16(v[6], v[7]);
                    *(u32x4*)(O + (size_t)row * ldc + col) = w; } }
    }
};
struct FnIn0 {
    const float* rope;
    __device__ __forceinline__ void operator()(int row, int col, float (&v)[8]) const {
        if (col < 640) {
            if (row < MLAT) {
                const int s = row & (SEQ - 1), p0 = (col & 63) >> 1, pos = p0 < 16 ? (s >> 6) : (s & 63), f0 = p0 & 15;
                const f32x4* t = (const f32x4*)(rope + (pos * 16 + f0) * 2);
                const f32x4 t0 = t[0], t1 = t[1];
                const float c[4] = {t0[0], t0[2], t1[0], t1[2]}, sn[4] = {t0[1], t0[3], t1[1], t1[3]};
#pragma unroll
                for (int i = 0; i < 4; ++i) { const float x1 = v[2 * i], x2 = v[2 * i + 1]; v[2 * i] = x1 * c[i] - x2 * sn[i]; v[2 * i + 1] = x1 * sn[i] + x2 * c[i]; }
            }
            if (col < 512) {
#pragma unroll
                for (int j = 0; j < 8; ++j) v[j] *= 0.125f;
            }
        } else if (col >= 768) {
#pragma unroll
            for (int j = 0; j < 8; ++j) v[j] = 0.5f * v[j] * (1.0f + erff(v[j] * 0.70710678118654752f));
        }
    }
};
struct FnIn1 {
    __device__ __forceinline__ void operator()(int, int col, float (&v)[8]) const {
        if (col < DM) {
#pragma unroll
            for (int j = 0; j < 8; ++j) v[j] *= 0.125f;
        }
    }
};
struct FnRelu2 {
    __device__ __forceinline__ void operator()(int, int, float (&v)[8]) const {
#pragma unroll
        for (int j = 0; j < 8; ++j) { const float r = fmaxf(v[j], 0.f); v[j] = r * r; }
    }
};
struct EpiRes {
    static constexpr bool PERM = false, AFTER_DRAIN = false;
    const float* res_lat; const float* res_ctx; float* out_lat; float* out_ctx; const float* gate;
    __device__ __forceinline__ void operator()(const f32x4 (&acc)[2][2][4][2], const Unit& u, int wr, int wc, int fr, int fq) const {
        const int row0 = u.pm * BM + wr * 64 + fr, col0 = u.pn * BM + wc * 32 + 4 * fq;
        const int mr = u.pm < (MLAT / BM) ? (u.pm >> 4) : NBATCH;
        const float* g = gate + (size_t)mr * MODW;
        f32x4 gv[2][2];
#pragma unroll
        for (int bj = 0; bj < 2; ++bj)
#pragma unroll
            for (int n = 0; n < 2; ++n) gv[bj][n] = *(const f32x4*)(g + col0 + bj * HALF + n * 16);
#pragma unroll
        for (int ai = 0; ai < 2; ++ai)
#pragma unroll
            for (int m = 0; m < 4; ++m) { const int row = row0 + ai * HALF + m * 16;
                const float* rp; float* op;
                if (row < MLAT) { rp = res_lat + (size_t)row * DM; op = out_lat + (size_t)row * DM; } else { rp = res_ctx + (size_t)(row - MLAT) * DM; op = out_ctx + (size_t)(row - MLAT) * DM; }
#pragma unroll
                for (int bj = 0; bj < 2; ++bj)
#pragma unroll
                    for (int n = 0; n < 2; ++n) { const int c = col0 + bj * HALF + n * 16; const f32x4 x = *(const f32x4*)(rp + c);
                        *(f32x4*)(op + c) = x * ALPHA + gv[bj][n] * acc[ai][bj][m][n]; }
                if (m & 1) asm volatile("" ::: "memory"); }
    }
};

template <class Epi, class Sched, bool ALIGN_EPI = false, bool SP2 = false>
__device__ __forceinline__ void gemm_phase(PG8_LAS unsigned char* lds, const Gemm g, const Sched& S, const Epi& E) {
    const int tid = threadIdx.x, wid = __builtin_amdgcn_readfirstlane(tid >> 6), lane = tid & 63, wr = wid >> 2, wc = wid & 3, fr = lane & 15, fq = lane >> 4;
    const int K = g.K, nt = K / BK;
    unsigned voffA[2], voffB[2];
#pragma unroll
    for (int i = 0; i < 2; ++i) { int R, C; stage_rc(tid * 16 + i * 8192, R, C); const int Rb = Epi::PERM ? ((R & ~31) + perm32(R & 31)) : R;
        voffA[i] = (unsigned)(R * K + C) * 2u; voffB[i] = (unsigned)(Rb * K + C) * 2u; }
    const size_t kstep = (size_t)(BK * 2);
    const size_t hstep = (size_t)HALF * K * 2;
    const size_t tstep = 2 * hstep;
    const unsigned ldsw = (unsigned)wid * 1024u;
    const int aoff = lds_byte(wr * 64 + fr, fq * 8), boff = lds_byte(wc * 32 + fr, fq * 8);
#define PG8_SA(b, h) (((b) * 2 + (h)) * HTB)
#define PG8_SB(b, h) ((4 + (b) * 2 + (h)) * HTB)
#define PG8_STAGE(bufoff, gbase, voff) do { _Pragma("unroll") for (int _i = 0; _i < 2; ++_i) \
        __builtin_amdgcn_global_load_lds((const unsigned*)((const char*)(gbase) + (voff)[_i]), (PG8_LAS unsigned*)(lds + (bufoff) + ldsw + _i * 8192), 16, 0, 0); } while (0)
#define PG8_LDA(dst, b, h) do { _Pragma("unroll") for (int m = 0; m < 4; ++m) _Pragma("unroll") for (int k = 0; k < 2; ++k) dst[m][k] = *(const PG8_LAS bf16x8*)(lds + PG8_SA(b, h) + aoff + m * 2048 + k * 1024); } while (0)
#define PG8_LDB(dst, b, h) do { _Pragma("unroll") for (int n = 0; n < 2; ++n) _Pragma("unroll") for (int k = 0; k < 2; ++k) dst[n][k] = *(const PG8_LAS bf16x8*)(lds + PG8_SB(b, h) + boff + n * 2048 + k * 1024); } while (0)
#define PG8_MMA(ai, bj, At, Bt) do { __builtin_amdgcn_s_setprio(1); _Pragma("unroll") for (int m = 0; m < 4; ++m) _Pragma("unroll") for (int n = 0; n < 2; ++n) _Pragma("unroll") for (int k = 0; k < 2; ++k) \
        acc[ai][bj][m][n] = __builtin_amdgcn_mfma_f32_16x16x32_bf16(Bt[n][k], At[m][k], acc[ai][bj][m][n], 0, 0, 0); __builtin_amdgcn_s_setprio(0); } while (0)
#define PG8_WAIT_V(n) asm volatile("s_waitcnt vmcnt(" #n ")" ::: "memory")
#define PG8_WAIT_L(n) asm volatile("s_waitcnt lgkmcnt(" #n ")" ::: "memory")
#define PG8_BAR __builtin_amdgcn_s_barrier()
#define PG8_SCHED __builtin_amdgcn_sched_barrier(0)
    Unit cur, nxt; int ui = 0;
    if (!S.next(0, cur)) return;
    f32x4 acc[2][2][4][2];
#pragma unroll
    for (int a = 0; a < 2; ++a)
#pragma unroll
        for (int b = 0; b < 2; ++b)
#pragma unroll
            for (int m = 0; m < 4; ++m)
#pragma unroll
                for (int n = 0; n < 2; ++n) acc[a][b][m][n] = (f32x4){0.f, 0.f, 0.f, 0.f};
    bf16x8 At[4][2], B0[2][2], B1[2][2];
    const char* cA = (const char*)g.A + (size_t)cur.pm * tstep; const char* cB = (const char*)g.Bt + (size_t)cur.pn * tstep;
    S.a_ready(cur);
    if constexpr (SP2) {
        PG8_STAGE(PG8_SB(0, 0), cB, voffB); PG8_STAGE(PG8_SB(0, 1), cB + hstep, voffB); PG8_STAGE(PG8_SA(0, 0), cA, voffA); PG8_STAGE(PG8_SA(0, 1), cA + hstep, voffA);
        if (wr == 1) PG8_BAR;
        PG8_WAIT_V(2); PG8_BAR;
        PG8_STAGE(PG8_SB(1, 0), cB + kstep, voffB); PG8_STAGE(PG8_SA(1, 0), cA + kstep, voffA); PG8_STAGE(PG8_SB(1, 1), cB + hstep + kstep, voffB);
        PG8_WAIT_V(6); PG8_BAR;
    } else {
        PG8_STAGE(PG8_SB(0, 0), cB, voffB); PG8_STAGE(PG8_SA(0, 0), cA, voffA); PG8_STAGE(PG8_SB(0, 1), cB + hstep, voffB); PG8_STAGE(PG8_SA(0, 1), cA + hstep, voffA);
        if (wr == 1) PG8_BAR;
        PG8_WAIT_V(4); PG8_BAR;
        PG8_STAGE(PG8_SB(1, 0), cB + kstep, voffB); PG8_STAGE(PG8_SA(1, 0), cA + kstep, voffA); PG8_STAGE(PG8_SB(1, 1), cB + hstep + kstep, voffB);
        PG8_WAIT_V(6); PG8_BAR;
    }
    for (;;) {
        const bool has_next = S.next(ui + 1, nxt);
        const char* nA = has_next ? (const char*)g.A + (size_t)nxt.pm * tstep : cA; const char* nB = has_next ? (const char*)g.Bt + (size_t)nxt.pn * tstep : cB;
        for (int t = 0; t < nt; t += 2) {
            const bool last = (t == nt - 2);
            const char* a1 = cA + (size_t)(t + 1) * kstep;
            const char* a2 = last ? nA : cA + (size_t)(t + 2) * kstep; const char* b2 = last ? nB : cB + (size_t)(t + 2) * kstep;
            const char* a3 = a2 + kstep; const char* b3 = b2 + kstep;
            if (last && has_next) S.a_ready(nxt);
            if constexpr (SP2) {
            PG8_LDB(B0, 0, 0); PG8_LDB(B1, 0, 1); PG8_SCHED; PG8_LDA(At, 0, 0); PG8_STAGE(PG8_SA(1, 1), a1 + hstep, voffA);
            PG8_WAIT_V(8); PG8_WAIT_L(0); PG8_BAR; PG8_MMA(0, 0, At, B0); PG8_MMA(0, 1, At, B1); PG8_BAR; PG8_SCHED;
            PG8_LDA(At, 0, 1); PG8_STAGE(PG8_SB(0, 0), b2, voffB); PG8_STAGE(PG8_SB(0, 1), b2 + hstep, voffB); PG8_STAGE(PG8_SA(0, 0), a2, voffA);
            PG8_WAIT_V(8); PG8_WAIT_L(0); PG8_BAR; PG8_MMA(1, 0, At, B0); PG8_MMA(1, 1, At, B1); PG8_BAR; PG8_SCHED;
            PG8_LDB(B0, 1, 0); PG8_LDB(B1, 1, 1); PG8_SCHED; PG8_LDA(At, 1, 0); PG8_STAGE(PG8_SA(0, 1), a2 + hstep, voffA);
            PG8_WAIT_V(8); PG8_WAIT_L(0); PG8_BAR; PG8_MMA(0, 0, At, B0); PG8_MMA(0, 1, At, B1); PG8_BAR; PG8_SCHED;
            PG8_LDA(At, 1, 1); PG8_STAGE(PG8_SB(1, 0), b3, voffB); PG8_STAGE(PG8_SB(1, 1), b3 + hstep, voffB); PG8_STAGE(PG8_SA(1, 0), a3, voffA);
            PG8_WAIT_V(8); PG8_WAIT_L(0); PG8_BAR; PG8_MMA(1, 0, At, B0); PG8_MMA(1, 1, At, B1); PG8_BAR; PG8_SCHED;
            } else {
            PG8_LDB(B0, 0, 0); PG8_SCHED; PG8_LDA(At, 0, 0); PG8_STAGE(PG8_SA(1, 1), a1 + hstep, voffA);
            PG8_WAIT_L(8); PG8_BAR; PG8_WAIT_L(0); PG8_MMA(0, 0, At, B0); PG8_BAR; PG8_SCHED;
            PG8_LDB(B1, 0, 1); PG8_STAGE(PG8_SB(0, 0), b2, voffB);
            PG8_BAR; PG8_WAIT_L(0); PG8_MMA(0, 1, At, B1); PG8_BAR;
            PG8_LDA(At, 0, 1); PG8_STAGE(PG8_SA(0, 0), a2, voffA);
            PG8_BAR; PG8_WAIT_L(0); PG8_MMA(1, 0, At, B0); PG8_BAR; PG8_SCHED;
            PG8_STAGE(PG8_SB(0, 1), b2 + hstep, voffB);
            PG8_WAIT_V(6); PG8_BAR; PG8_MMA(1, 1, At, B1); PG8_BAR;
            PG8_LDB(B0, 1, 0); PG8_SCHED; PG8_LDA(At, 1, 0); PG8_STAGE(PG8_SA(0, 1), a2 + hstep, voffA);
            PG8_WAIT_L(8); PG8_BAR; PG8_WAIT_L(0); PG8_MMA(0, 0, At, B0); PG8_BAR; PG8_SCHED;
            PG8_LDB(B1, 1, 1); PG8_STAGE(PG8_SB(1, 0), b3, voffB);
            PG8_BAR; PG8_WAIT_L(0); PG8_MMA(0, 1, At, B1); PG8_BAR;
            PG8_LDA(At, 1, 1); PG8_STAGE(PG8_SA(1, 0), a3, voffA);
            PG8_BAR; PG8_WAIT_L(0); PG8_MMA(1, 0, At, B0); PG8_BAR; PG8_SCHED;
            PG8_STAGE(PG8_SB(1, 1), b3 + hstep, voffB);
            PG8_WAIT_V(6); PG8_BAR; PG8_MMA(1, 1, At, B1); PG8_BAR;
            }
        }
        if constexpr (ALIGN_EPI) { if (wr == 0) PG8_BAR; }
        if constexpr (!Epi::AFTER_DRAIN) { E(acc, cur, wr, wc, fr, fq); S.done(cur); }
        if (!has_next) break;
#pragma unroll
        for (int a = 0; a < 2; ++a)
#pragma unroll
            for (int b = 0; b < 2; ++b)
#pragma unroll
                for (int m = 0; m < 4; ++m)
#pragma unroll
                    for (int n = 0; n < 2; ++n) acc[a][b][m][n] = (f32x4){0.f, 0.f, 0.f, 0.f};
        cur = nxt; cA = nA; cB = nB; ++ui;
        if constexpr (ALIGN_EPI) { if (wr == 1) PG8_BAR; }
    }
    PG8_WAIT_V(0);
    if constexpr (!ALIGN_EPI) { if (wr == 0) PG8_BAR; }
    PG8_BAR;
    if constexpr (Epi::AFTER_DRAIN) { E.fused(acc, cur, wr, wc, fr, fq, lds, wid, lane); S.done(cur); }
#undef PG8_SA
#undef PG8_SB
#undef PG8_STAGE
#undef PG8_LDA
#undef PG8_LDB
#undef PG8_MMA
#undef PG8_WAIT_V
#undef PG8_WAIT_L
#undef PG8_BAR
#undef PG8_SCHED
}
}

#ifndef MK_N_LAUNCHES
#define MK_N_LAUNCHES 1
#endif
constexpr int NPH = 16;
constexpr int NWAVES = 8, NTHR = NWAVES * 64;
constexpr int LDS_BYTES = 147456;
#define LAS __attribute__((address_space(3)))
typedef unsigned short bf16;
typedef float f32x4 __attribute__((ext_vector_type(4)));
typedef unsigned v4u __attribute__((ext_vector_type(4)));
typedef unsigned v2u __attribute__((ext_vector_type(2)));
using pg8::bf2f; using pg8::bflo; using pg8::bfhi; using pg8::cvt_pk_bf16;

constexpr size_t MiB = 1u << 20;
constexpr size_t WS_CTL = 0, CTL_ZERO_BYTES = 1 * MiB;
constexpr size_t WS_MOD = 1 * MiB;
constexpr size_t WS_ROPE = 1 * MiB + 512 * 1024;
constexpr size_t WS_WABIN = 2 * MiB, WS_WABOUT = 6 * MiB, WS_WCIN = 8 * MiB, WS_WCOUT = 14 * MiB, WS_W1 = 16 * MiB, WS_W2 = 32 * MiB;
constexpr size_t WS_XRC = 48 * MiB;
constexpr size_t WS_ACT = 56 * MiB;
constexpr size_t WS_BIG = 128 * MiB;
constexpr size_t WS_END = 400 * MiB;
static_assert(WS_ACT + (size_t)MALL * DM * 2 <= WS_BIG && WS_BIG + (size_t)MALL * FF * 2 <= WS_END, "d_ws map");

struct Args { const float* in[22]; float* out; unsigned char* ws; float freq[16]; int ph_lo, ph_hi; };
enum { I_X = 0, I_C, I_CTX, I_CCTX, I_WMOD, I_BMOD, I_ABWIN, I_SINK, I_BLNG, I_BLNB, I_BWS, I_BBS, I_ABWOUT, I_CWIN, I_RPB, I_CWOUT, I_LN1G, I_LN1B, I_W1, I_W2, I_LN2G, I_LN2B };

__device__ __forceinline__ float wave_sum(float v) {
#pragma unroll
    for (int o = 1; o < 64; o <<= 1) v += __shfl_xor(v, o);
    return v;
}
__device__ __forceinline__ unsigned f2bf(float f) { unsigned u = __builtin_bit_cast(unsigned, f); return (u + 0x7fffu + ((u >> 16) & 1u)) >> 16; }
__device__ __forceinline__ unsigned pk2(float lo, float hi) { return f2bf(lo) | (f2bf(hi) << 16); }

__device__ __forceinline__ void sincos_d(double x, double& s, double& c) {
    const double kd = rint(x * 0.63661977236758134308); const int k = (int)kd;
    const double r = (x - kd * 1.57079632679489655800) - kd * 6.12323399573676603587e-17, r2 = r * r;
    const double sp = r * (1.0 + r2 * (-1.0 / 6.0 + r2 * (1.0 / 120.0 + r2 * (-1.0 / 5040.0 + r2 * (1.0 / 362880.0 + r2 * (-1.0 / 39916800.0 + r2 * (1.0 / 6227020800.0 + r2 * (-1.0 / 1307674368000.0))))))));
    const double cp = 1.0 + r2 * (-0.5 + r2 * (1.0 / 24.0 + r2 * (-1.0 / 720.0 + r2 * (1.0 / 40320.0 + r2 * (-1.0 / 3628800.0 + r2 * (1.0 / 479001600.0 + r2 * (-1.0 / 87178291200.0 + r2 * (1.0 / 20922789888000.0))))))));
    const int q = k & 3;
    s = q == 0 ? sp : q == 1 ? cp : q == 2 ? -sp : -cp;
    c = q == 0 ? cp : q == 1 ? -sp : q == 2 ? -cp : sp;
}

__device__ __forceinline__ void p0_transpose_item(const float* W, int K, int N, bf16* WT, LAS float* scr, int item, int lane) {
    const int nblk = N / 32, kb = item / nblk, nb = item % nblk, k0 = 64 * kb, n0 = 32 * nb;
#pragma unroll 8
    for (int i = 0; i < 32; ++i) { const int kk = 2 * i + (lane >> 5); scr[kk * 33 + (lane & 31)] = W[(size_t)(k0 + kk) * N + n0 + (lane & 31)]; }
    asm volatile("s_waitcnt lgkmcnt(0)" ::: "memory");
    const int c = lane & 7;
#pragma unroll
    for (int j = 0; j < 4; ++j) { const int n = (lane >> 3) + 8 * j; const LAS float* s = scr + (8 * c) * 33 + n;
        v4u o; o.x = pk2(s[0 * 33], s[1 * 33]); o.y = pk2(s[2 * 33], s[3 * 33]); o.z = pk2(s[4 * 33], s[5 * 33]); o.w = pk2(s[6 * 33], s[7 * 33]);
        *(v4u*)(WT + (size_t)(n0 + n) * K + k0 + 8 * c) = o; }
    asm volatile("s_waitcnt lgkmcnt(0)" ::: "memory");
}

__device__ __forceinline__ void p0_mod_item(const Args& a, LAS unsigned char* lds, int item, int tid, int lane, int wave) {
    LAS float* sc = (LAS float*)lds;
    LAS float* red = sc + 9 * DM;
    const int l = item / 96, strip = item % 96;
    const float* c = a.in[I_C]; const float* cc = a.in[I_CCTX];
    for (int i = tid; i < 9 * DM; i += NTHR) { const int r = i >> 10, k = i & (DM - 1); const float v = r < NBATCH ? c[r * DM + k] : cc[k]; sc[i] = v / (1.0f + expf(-v)); }
    __syncthreads();
    const float* w = a.in[I_WMOD] + (size_t)l * DM * MODW + strip * 64 + lane;
    float acc[9];
#pragma unroll
    for (int r = 0; r < 9; ++r) acc[r] = 0.f;
    const int k0 = wave * 128;
#pragma unroll 4
    for (int k = k0; k < k0 + 128; ++k) { const float wv = w[(size_t)k * MODW];
#pragma unroll
        for (int r = 0; r < 9; ++r) acc[r] = fmaf(sc[r * DM + k], wv, acc[r]); }
#pragma unroll
    for (int r = 0; r < 9; ++r) red[(wave * 9 + r) * 64 + lane] = acc[r];
    __syncthreads();
    float* mod = (float*)(a.ws + WS_MOD);
    for (int i = tid; i < 9 * 64; i += NTHR) { const int r = i >> 6, ln = i & 63; float s = 0.f;
#pragma unroll
        for (int wv = 0; wv < 8; ++wv) s += red[(wv * 9 + r) * 64 + ln];
        const int n = strip * 64 + ln; mod[(size_t)(l * 9 + r) * MODW + n] = s + a.in[I_BMOD][l * MODW + n]; }
    __syncthreads();
}

__device__ __forceinline__ void ph0_prologue(const Args& a, LAS unsigned char* lds, int tid, int lane, int wave, int bid, int G) {
    if (bid == G - 1) {
        float* rope = (float*)(a.ws + WS_ROPE);
        for (int i = tid; i < 64 * 16; i += NTHR) { const int pos = i >> 4, f = i & 15; const float ang = (float)pos * a.freq[f]; double s, c; sincos_d((double)ang, s, c); rope[2 * i] = (float)c; rope[2 * i + 1] = (float)s; }
    }
    for (int item = bid; item < 192; item += G) p0_mod_item(a, lds, item, tid, lane, wave);
    LAS float* scr = (LAS float*)(lds + wave * 16384);
    const int gw = bid * NWAVES + wave, NGW = G * NWAVES;
    constexpr int I_A = (DM / 64) * (ABIN / 32), I_O = (DM / 64) * (DM / 32), I_CI = (DM / 64) * (CIN / 32), I_U = (DM / 64) * (FF / 32), I_D = (FF / 64) * (DM / 32);
    constexpr int NITEMS = I_A + I_O + I_CI + I_O + 2 * I_U + 2 * I_D;
    unsigned char* ws = a.ws;
    for (int it = gw; it < NITEMS; it += NGW) {
        int r = it;
        if (r < I_A) { p0_transpose_item(a.in[I_ABWIN], DM, ABIN, (bf16*)(ws + WS_WABIN), scr, r, lane); continue; } r -= I_A;
        if (r < I_O) { p0_transpose_item(a.in[I_ABWOUT], DM, DM, (bf16*)(ws + WS_WABOUT), scr, r, lane); continue; } r -= I_O;
        if (r < I_CI) { p0_transpose_item(a.in[I_CWIN], DM, CIN, (bf16*)(ws + WS_WCIN), scr, r, lane); continue; } r -= I_CI;
        if (r < I_O) { p0_transpose_item(a.in[I_CWOUT], DM, DM, (bf16*)(ws + WS_WCOUT), scr, r, lane); continue; } r -= I_O;
        if (r < 2 * I_U) { const int l = r / I_U; p0_transpose_item(a.in[I_W1] + (size_t)l * DM * FF, DM, FF, (bf16*)(ws + WS_W1 + (size_t)l * 8 * MiB), scr, r % I_U, lane); continue; } r -= 2 * I_U;
        { const int l = r / I_D; p0_transpose_item(a.in[I_W2] + (size_t)l * DM * FF, FF, DM, (bf16*)(ws + WS_W2 + (size_t)l * 8 * MiB), scr, r % I_D, lane); }
    }
}

__device__ __forceinline__ float* xr_row(const Args& a, int row) { return row < MLAT ? a.out + (size_t)row * DM : (float*)(a.ws + WS_XRC) + (size_t)(row - MLAT) * DM; }
__device__ __forceinline__ int mod_row(int row) { return row < MLAT ? (row >> 12) : NBATCH; }

__device__ __forceinline__ void ph1_modulate(const Args& a, int lane, int gw, int NGW) {
    const float* mod0 = (const float*)(a.ws + WS_MOD);
    bf16* act = (bf16*)(a.ws + WS_ACT);
    for (int row = gw; row < MALL; row += NGW) {
        const float* src = row < MLAT ? a.in[I_X] + (size_t)row * DM : a.in[I_CTX] + (size_t)(row - MLAT) * DM;
        const float* mr = mod0 + (size_t)mod_row(row) * MODW;
#pragma unroll
        for (int j = 0; j < 4; ++j) { const int c = 4 * lane + 256 * j; const f32x4 v = *(const f32x4*)(src + c), sh = *(const f32x4*)(mr + c), sc = *(const f32x4*)(mr + DM + c);
            const f32x4 h = v * (sc + 1.0f) + sh; v2u o; o.x = pk2(h[0], h[1]); o.y = pk2(h[2], h[3]); *(v2u*)(act + (size_t)row * DM + c) = o; }
    }
}

__device__ __forceinline__ void ph_layernorm(const Args& a, int nrows, const float* gam, const float* bet, const float* modv, int lane, int gw, int NGW) {
    bf16* act = (bf16*)(a.ws + WS_ACT);
    for (int row = gw; row < nrows; row += NGW) {
        float* xr = xr_row(a, row);
        f32x4 v[4]; float s = 0.f;
#pragma unroll
        for (int j = 0; j < 4; ++j) { v[j] = *(const f32x4*)(xr + 4 * lane + 256 * j); s += (v[j][0] + v[j][1]) + (v[j][2] + v[j][3]); }
        const float mean = wave_sum(s) * (1.0f / DM); float s2 = 0.f;
#pragma unroll
        for (int j = 0; j < 4; ++j) { v[j] = v[j] - mean; s2 += (v[j][0] * v[j][0] + v[j][1] * v[j][1]) + (v[j][2] * v[j][2] + v[j][3] * v[j][3]); }
        const float rstd = 1.0f / sqrtf(wave_sum(s2) * (1.0f / DM) + LN_EPS);
#pragma unroll
        for (int j = 0; j < 4; ++j) { const int c = 4 * lane + 256 * j; const f32x4 y = v[j] * rstd * *(const f32x4*)(gam + c) + *(const f32x4*)(bet + c);
            *(f32x4*)(xr + c) = y;
            if (modv) { const float* mr = modv + (size_t)mod_row(row) * MODW; const f32x4 h = y * (*(const f32x4*)(mr + DM + c) + 1.0f) + *(const f32x4*)(mr + c);
                v2u o; o.x = pk2(h[0], h[1]); o.y = pk2(h[2], h[3]); *(v2u*)(act + (size_t)row * DM + c) = o; } }
    }
}

__device__ __forceinline__ void attn_key(const bf16* kp, const bf16* vp, bool valid, float bias, const float (&q)[64], float (&o)[64], float& m, float& l) {
    float dot = 0.f;
#pragma unroll
    for (int c = 0; c < 8; ++c) { const v4u kk = ((const v4u*)kp)[c];
        dot = fmaf(q[8 * c + 0], bflo(kk.x), dot); dot = fmaf(q[8 * c + 1], bfhi(kk.x), dot); dot = fmaf(q[8 * c + 2], bflo(kk.y), dot); dot = fmaf(q[8 * c + 3], bfhi(kk.y), dot);
        dot = fmaf(q[8 * c + 4], bflo(kk.z), dot); dot = fmaf(q[8 * c + 5], bfhi(kk.z), dot); dot = fmaf(q[8 * c + 6], bflo(kk.w), dot); dot = fmaf(q[8 * c + 7], bfhi(kk.w), dot); }
    const float sc = valid ? dot + bias : -1e30f;
    const float mn = fmaxf(m, sc), corr = __expf(m - mn), p = __expf(sc - mn);
    l = l * corr + p; m = mn;
#pragma unroll
    for (int c = 0; c < 8; ++c) { const v4u vv = ((const v4u*)vp)[c];
        o[8 * c + 0] = fmaf(o[8 * c + 0], corr, p * bflo(vv.x)); o[8 * c + 1] = fmaf(o[8 * c + 1], corr, p * bfhi(vv.x)); o[8 * c + 2] = fmaf(o[8 * c + 2], corr, p * bflo(vv.y)); o[8 * c + 3] = fmaf(o[8 * c + 3], corr, p * bfhi(vv.y));
        o[8 * c + 4] = fmaf(o[8 * c + 4], corr, p * bflo(vv.z)); o[8 * c + 5] = fmaf(o[8 * c + 5], corr, p * bfhi(vv.z)); o[8 * c + 6] = fmaf(o[8 * c + 6], corr, p * bflo(vv.w)); o[8 * c + 7] = fmaf(o[8 * c + 7], corr, p * bfhi(vv.w)); }
}
__device__ __forceinline__ void load_q64(const bf16* qp, float (&q)[64]) {
#pragma unroll
    for (int c = 0; c < 8; ++c) { const v4u t = ((const v4u*)qp)[c]; q[8 * c + 0] = bflo(t.x); q[8 * c + 1] = bfhi(t.x); q[8 * c + 2] = bflo(t.y); q[8 * c + 3] = bfhi(t.y); q[8 * c + 4] = bflo(t.z); q[8 * c + 5] = bfhi(t.z); q[8 * c + 6] = bflo(t.w); q[8 * c + 7] = bfhi(t.w); }
}
__device__ __forceinline__ void store_o64(bf16* op, const float (&o)[64], float inv) {
#pragma unroll
    for (int c = 0; c < 8; ++c) { v4u w; w.x = pk2(o[8 * c + 0] * inv, o[8 * c + 1] * inv); w.y = pk2(o[8 * c + 2] * inv, o[8 * c + 3] * inv); w.z = pk2(o[8 * c + 4] * inv, o[8 * c + 5] * inv); w.w = pk2(o[8 * c + 6] * inv, o[8 * c + 7] * inv); ((v4u*)op)[c] = w; }
}
__device__ __forceinline__ void l0_attn_item_naive(const Args& a, int item, int lane, int wave) {
    const bf16* Z = (const bf16*)(a.ws + WS_BIG); bf16* AB = (bf16*)(a.ws + WS_ACT);
    const int row = item * 64 + lane, h = wave, hkv = h >> 2;
    const bool latent = item < MLAT / 64;
    const int b = latent ? item >> 6 : (item - MLAT / 64) >> 2;
    float q[64], o[64];
    load_q64(Z + (size_t)row * ABIN + 64 * h, q);
#pragma unroll
    for (int d = 0; d < 64; ++d) o[d] = 0.f;
    float m = a.in[I_SINK][h], l = 1.0f;
    const bf16* kc = Z + (size_t)(MLAT + b * CTXL) * ABIN + 512 + 64 * hkv;
    for (int j = 0; j < CTXL; ++j) attn_key(kc + (size_t)j * ABIN, kc + (size_t)j * ABIN + 128, true, 0.f, q, o, m, l);
    if (latent) {
        const int s0 = (item & 63) * 64, s = s0 + lane, lo = s0 - 128 < 0 ? 0 : s0 - 128, hi = s0 + 191 > SEQ - 1 ? SEQ - 1 : s0 + 191;
        const bf16* kl = Z + (size_t)(b * SEQ) * ABIN + 512 + 64 * hkv;
        for (int kp = lo; kp <= hi; ++kp) { const int d = s - kp; attn_key(kl + (size_t)kp * ABIN, kl + (size_t)kp * ABIN + 128, d <= 128 && d >= -128, 0.f, q, o, m, l); }
    }
    store_o64(AB + (size_t)row * DM + 64 * h, o, 1.0f / l);
}
__device__ __forceinline__ void l0_gate_chunk_naive(const Args& a, LAS unsigned char* lds, int chunk, int tid, int lane, int wave) {
    const bf16* Z = (const bf16*)(a.ws + WS_BIG); bf16* AB = (bf16*)(a.ws + WS_ACT);
    LAS float* st = (LAS float*)lds;
    LAS float* vn = st + 256;
    const int base = chunk * 128;
    for (int i = 0; i < 16; ++i) { const int r = wave * 16 + i; const v4u t = *(const v4u*)(Z + (size_t)(base + r) * ABIN + 1280 + lane * 8);
        float x[8] = {bflo(t.x), bfhi(t.x), bflo(t.y), bfhi(t.y), bflo(t.z), bfhi(t.z), bflo(t.w), bfhi(t.w)}; float s = 0.f;
#pragma unroll
        for (int j = 0; j < 8; ++j) s += x[j];
        const float mean = wave_sum(s) * (1.0f / 512.0f); float s2 = 0.f;
#pragma unroll
        for (int j = 0; j < 8; ++j) { const float d = x[j] - mean; s2 += d * d; }
        const float var = wave_sum(s2) * (1.0f / 512.0f);
        if (lane == 0) { st[2 * r] = mean; st[2 * r + 1] = 1.0f / sqrtf(var + LN_EPS); } }
    __syncthreads();
    const float* wsg = a.in[I_BWS]; const float* bs = a.in[I_BBS];
    for (int g = 0; g < 8; ++g) {
        { const int c = tid & 63; const float lg = a.in[I_BLNG][g * 64 + c], lb = a.in[I_BLNB][g * 64 + c];
          for (int i = 0; i < 16; ++i) { const int qq = (tid >> 6) + 8 * i; const float x = bf2f(Z[(size_t)(base + qq) * ABIN + 1280 + g * 64 + c]); vn[qq * 64 + c] = (x - st[2 * qq]) * st[2 * qq + 1] * lg + lb; } }
        __syncthreads();
        float acc[16];
#pragma unroll
        for (int j = 0; j < 16; ++j) acc[j] = 0.f;
        const float* wrow = wsg + (size_t)(g * 128 + wave * 16) * 128;
        for (int qq = 0; qq < 128; ++qq) { const float v = vn[qq * 64 + lane];
#pragma unroll
            for (int j = 0; j < 16; ++j) acc[j] = fmaf(wrow[j * 128 + qq], v, acc[j]); }
#pragma unroll
        for (int j = 0; j < 16; ++j) { const int p = wave * 16 + j; const size_t row = (size_t)(base + p); const float mixed = acc[j] + bs[g * 128 + p]; const float u = bf2f(Z[row * ABIN + 768 + g * 64 + lane]);
            AB[row * DM + 512 + g * 64 + lane] = (bf16)f2bf(u * mixed); }
        __syncthreads();
    }
}
__device__ __forceinline__ void l1_natten_item_naive(const Args& a, int item, int lane, int wave) {
    const bf16* Z = (const bf16*)(a.ws + WS_BIG); bf16* AC = (bf16*)(a.ws + WS_ACT);
    const int rg = item >> 1, h = (item & 1) * 8 + wave, row = rg * 64 + lane, b = rg >> 6, r = rg & 63, c = lane;
    const int r0 = r - 4 < 0 ? 0 : (r - 4 > 56 ? 56 : r - 4), qs = c - 8 < 0 ? 0 : (c - 8 > 48 ? 48 : c - 8);
    float q[64], o[64];
    load_q64(Z + (size_t)row * CIN + 64 * h, q);
#pragma unroll
    for (int d = 0; d < 64; ++d) o[d] = 0.f;
    float m = -1e30f, l = 0.f;
    const bf16* kc = Z + (size_t)(MLAT + b * CTXL) * CIN + DM + 64 * h;
    for (int j = 0; j < CTXL; ++j) attn_key(kc + (size_t)j * CIN, kc + (size_t)j * CIN + DM, true, 0.f, q, o, m, l);
    const float* rpb = a.in[I_RPB] + h * 465;
    for (int kr = r0; kr < r0 + 8; ++kr) {
        const bf16* kl = Z + (size_t)(b * SEQ + kr * 64) * CIN + DM + 64 * h; const float* brow = rpb + (kr - r + 7) * 31;
        for (int kcx = 0; kcx < 64; ++kcx) { int dc = kcx - c + 15; dc = dc < 0 ? 0 : (dc > 30 ? 30 : dc);
            attn_key(kl + (size_t)kcx * CIN, kl + (size_t)kcx * CIN + DM, kcx >= qs && kcx < qs + 16, brow[dc], q, o, m, l); }
    }
    store_o64(AC + (size_t)row * DM + 64 * h, o, 1.0f / l);
}


typedef float f32x16 __attribute__((ext_vector_type(16)));
typedef short bf16x8 __attribute__((ext_vector_type(8)));
typedef short s16x4 __attribute__((ext_vector_type(4)));
constexpr int KP = 144;
constexpr int TILE_B = 64 * KP;
constexpr float LOG2E = 1.4426950408889634f;
__device__ __forceinline__ int crow(int r, int hi) { return (r & 3) + 8 * (r >> 2) + 4 * hi; }
__device__ __forceinline__ s16x4 tr_read(const LAS unsigned char* p) { return __builtin_bit_cast(s16x4, __builtin_amdgcn_ds_read_tr16_b64_v4i16((LAS s16x4*)p)); }
struct QT { f32x16 o0, o1; float m, l; };
struct MfNone { __device__ __forceinline__ float operator()(float s, int, int) const { return s * LOG2E; } };
struct MfWin { int dq;
    __device__ __forceinline__ float operator()(float s, int r, int hi) const { const int d = dq - crow(r, hi); return (d > 128 || d < -128) ? -1e30f : s * LOG2E; } };
struct MfNat { const LAS float* brow; int cq, qs, kc0; bool rowok;
    __device__ __forceinline__ float operator()(float s, int r, int hi) const { const int kc = kc0 + crow(r, hi); int dc = kc - cq + 15; dc = dc < 0 ? 0 : (dc > 30 ? 30 : dc);
        const bool ok = rowok && kc >= qs && kc < qs + 16; return ok ? (s + brow[dc]) * LOG2E : -1e30f; } };
template <class MF> __device__ __forceinline__ void attn_sub32(const LAS unsigned char* Ks, const LAS unsigned char* Vs, const bf16x8 (&qf)[4], QT& st, int lane, const MF& mf) {
    const int r32 = lane & 31, hi = lane >> 5;
    f32x16 s;
#pragma unroll
    for (int r = 0; r < 16; ++r) s[r] = 0.f;
    const LAS unsigned char* kp = Ks + r32 * KP + hi * 16;
#pragma unroll
    for (int ks = 0; ks < 4; ++ks) { const bf16x8 kf = *(const LAS bf16x8*)(kp + ks * 32); s = __builtin_amdgcn_mfma_f32_32x32x16_bf16(kf, qf[ks], s, 0, 0, 0); }
    float mx = -1e30f;
#pragma unroll
    for (int r = 0; r < 16; ++r) { const float t = mf(s[r], r, hi); s[r] = t; mx = fmaxf(mx, t); }
    mx = fmaxf(mx, __shfl_xor(mx, 32));
    const float mn = fmaxf(st.m, mx), corr = __builtin_amdgcn_exp2f(st.m - mn);
    st.m = mn; st.l *= corr; st.o0 = st.o0 * corr; st.o1 = st.o1 * corr;
    float ps = 0.f;
#pragma unroll
    for (int r = 0; r < 16; ++r) { const float p = __builtin_amdgcn_exp2f(s[r] - mn); s[r] = p; ps += p; }
    st.l += ps;
    const int g = lane >> 4, i = lane & 15;
    const LAS unsigned char* vp = Vs + (4 * (g >> 1) + (i >> 2)) * KP + (16 * (g & 1) + 4 * (i & 3)) * 2;
#pragma unroll
    for (int sp = 0; sp < 2; ++sp) {
        v4u pw; pw.x = cvt_pk_bf16(s[8 * sp + 0], s[8 * sp + 1]); pw.y = cvt_pk_bf16(s[8 * sp + 2], s[8 * sp + 3]); pw.z = cvt_pk_bf16(s[8 * sp + 4], s[8 * sp + 5]); pw.w = cvt_pk_bf16(s[8 * sp + 6], s[8 * sp + 7]);
        const bf16x8 pf = __builtin_bit_cast(bf16x8, pw);
        { const s16x4 lo = tr_read(vp + (16 * sp) * KP), hi4 = tr_read(vp + (16 * sp + 8) * KP); const bf16x8 vf = {lo[0], lo[1], lo[2], lo[3], hi4[0], hi4[1], hi4[2], hi4[3]};
          st.o0 = __builtin_amdgcn_mfma_f32_32x32x16_bf16(vf, pf, st.o0, 0, 0, 0); }
        { const s16x4 lo = tr_read(vp + (16 * sp) * KP + 64), hi4 = tr_read(vp + (16 * sp + 8) * KP + 64); const bf16x8 vf = {lo[0], lo[1], lo[2], lo[3], hi4[0], hi4[1], hi4[2], hi4[3]};
          st.o1 = __builtin_amdgcn_mfma_f32_32x32x16_bf16(vf, pf, st.o1, 0, 0, 0); }
    }
}
__device__ __forceinline__ void qt_init(QT& st, float m0, float l0) {
#pragma unroll
    for (int r = 0; r < 16; ++r) { st.o0[r] = 0.f; st.o1[r] = 0.f; }
    st.m = m0; st.l = l0;
}
__device__ __forceinline__ void qt_store(const QT& st, bf16* orow, int lane) {
    const int hi = lane >> 5; const float lt = st.l + __shfl_xor(st.l, 32), inv = 1.0f / lt;
#pragma unroll
    for (int gq = 0; gq < 4; ++gq) {
        v2u w0; w0.x = cvt_pk_bf16(st.o0[4 * gq + 0] * inv, st.o0[4 * gq + 1] * inv); w0.y = cvt_pk_bf16(st.o0[4 * gq + 2] * inv, st.o0[4 * gq + 3] * inv); *(v2u*)(orow + 8 * gq + 4 * hi) = w0;
        v2u w1; w1.x = cvt_pk_bf16(st.o1[4 * gq + 0] * inv, st.o1[4 * gq + 1] * inv); w1.y = cvt_pk_bf16(st.o1[4 * gq + 2] * inv, st.o1[4 * gq + 3] * inv); *(v2u*)(orow + 32 + 8 * gq + 4 * hi) = w1; }
}
__device__ __forceinline__ void l0_attn_unit(const Args& a, LAS unsigned char* lds, int unit, int tid, int lane, int wave) {
    const bf16* Z = (const bf16*)(a.ws + WS_BIG); bf16* AB = (bf16*)(a.ws + WS_ACT);
    const bool latent = unit < 512;
    int b, hkv, qb; if (latent) { b = unit >> 6; hkv = (unit >> 5) & 1; qb = unit & 31; } else { const int u2 = unit - 512; b = u2 >> 2; hkv = (u2 >> 1) & 1; qb = u2 & 1; }
    const int qrow0 = latent ? b * SEQ + qb * 128 : MLAT + b * CTXL + qb * 128;
    const int h = hkv * 4 + (wave >> 1), qw = 64 * (wave & 1), r32 = lane & 31, hi = lane >> 5;
    bf16x8 qf[2][4]; QT st[2];
#pragma unroll
    for (int qt = 0; qt < 2; ++qt) { const bf16* qp = Z + (size_t)(qrow0 + qw + 32 * qt + r32) * ABIN + 64 * h + 8 * hi;
#pragma unroll
        for (int ks = 0; ks < 4; ++ks) qf[qt][ks] = *(const bf16x8*)(qp + 16 * ks);
        qt_init(st[qt], a.in[I_SINK][h] * LOG2E, hi == 0 ? 1.0f : 0.0f); }
    const int s0 = qb * 128; int klo = 0, nloc = 0;
    if (latent) { klo = s0 - 128 < 0 ? 0 : s0 - 128; const int khi = s0 + 256 > SEQ ? SEQ : s0 + 256; nloc = (khi - klo) >> 6; }
    const int ntiles = 4 + nloc, key = tid >> 3, ch = tid & 7;
    const bf16* kbase = Z + 512 + 64 * hkv + 8 * ch;
    v4u kreg, vreg;
    { const bf16* p = kbase + (size_t)(MLAT + b * CTXL + key) * ABIN; kreg = *(const v4u*)p; vreg = *(const v4u*)(p + 128); }
    for (int t = 0; t < ntiles; ++t) {
        LAS unsigned char* Kt = lds + (t & 1) * (2 * TILE_B); LAS unsigned char* Vt = Kt + TILE_B;
        *(LAS v4u*)(Kt + key * KP + ch * 16) = kreg; *(LAS v4u*)(Vt + key * KP + ch * 16) = vreg;
        __syncthreads();
        if (t + 1 < ntiles) { const int rb = (t + 1 < 4) ? MLAT + b * CTXL + 64 * (t + 1) : b * SEQ + klo + 64 * (t + 1 - 4); const bf16* p = kbase + (size_t)(rb + key) * ABIN; kreg = *(const v4u*)p; vreg = *(const v4u*)(p + 128); }
#pragma unroll
        for (int qt = 0; qt < 2; ++qt)
#pragma unroll 1
            for (int sub = 0; sub < 2; ++sub) {
                const LAS unsigned char* Ks = Kt + 32 * sub * KP; const LAS unsigned char* Vs = Vt + 32 * sub * KP;
                if (t < 4) attn_sub32(Ks, Vs, qf[qt], st[qt], lane, MfNone{});
                else { const int sq0 = s0 + qw + 32 * qt, kp0 = klo + 64 * (t - 4) + 32 * sub;
                    if (kp0 - (sq0 + 31) > 128 || sq0 - (kp0 + 31) > 128) continue;
                    if ((sq0 + 31) - kp0 <= 128 && (kp0 + 31) - sq0 <= 128) attn_sub32(Ks, Vs, qf[qt], st[qt], lane, MfNone{});
                    else attn_sub32(Ks, Vs, qf[qt], st[qt], lane, MfWin{sq0 + r32 - kp0}); }
            }
    }
#pragma unroll
    for (int qt = 0; qt < 2; ++qt) qt_store(st[qt], AB + (size_t)(qrow0 + qw + 32 * qt + r32) * DM + 64 * h, lane);
    __syncthreads();
}
__device__ __forceinline__ void l1_natten_unit(const Args& a, LAS unsigned char* lds, int unit, int tid, int lane, int wave) {
    const bf16* Z = (const bf16*)(a.ws + WS_BIG); bf16* AC = (bf16*)(a.ws + WS_ACT);
    const int r4 = (unit & 15) * 4, h = (unit >> 4) & 15, b = unit >> 8;
    LAS float* btab = (LAS float*)(lds + 4 * TILE_B);
    for (int i = tid; i < 465; i += NTHR) btab[i] = a.in[I_RPB][h * 465 + i];
    const int rp = wave >> 2, j = wave & 3, r32 = lane & 31, hi = lane >> 5;
    const int r = r4 + 2 * rp + ((lane >> 4) & 1), c = 16 * j + (lane & 15), qrow = b * SEQ + r * 64 + c;
    const int r0l = r - 4 < 0 ? 0 : (r - 4 > 56 ? 56 : r - 4), qs = c - 8 < 0 ? 0 : (c - 8 > 48 ? 48 : c - 8);
    const int kc0 = 16 * j - 8 < 0 ? 0 : (16 * j - 8 > 32 ? 32 : 16 * j - 8);
    const int ra = r4 + 2 * rp, rb = ra + 1;
    const int r0a = ra - 4 < 0 ? 0 : (ra - 4 > 56 ? 56 : ra - 4), r0b = rb - 4 < 0 ? 0 : (rb - 4 > 56 ? 56 : rb - 4);
    bf16x8 qf[4]; QT st;
    { const bf16* qp = Z + (size_t)qrow * CIN + 64 * h + 8 * hi;
#pragma unroll
      for (int ks = 0; ks < 4; ++ks) qf[ks] = *(const bf16x8*)(qp + 16 * ks); }
    qt_init(st, -1e30f, 0.f);
    const int krlo = r4 - 4 < 0 ? 0 : (r4 - 4 > 56 ? 56 : r4 - 4); const int krhi = (r4 - 1 < 0 ? 0 : (r4 - 1 > 56 ? 56 : r4 - 1)) + 8;
    const int ntiles = 4 + (krhi - krlo), key = tid >> 3, ch = tid & 7;
    const bf16* kbase = Z + DM + 64 * h + 8 * ch;
    v4u kreg, vreg;
    { const bf16* p = kbase + (size_t)(MLAT + b * CTXL + key) * CIN; kreg = *(const v4u*)p; vreg = *(const v4u*)(p + DM); }
    for (int t = 0; t < ntiles; ++t) {
        LAS unsigned char* Kt = lds + (t & 1) * (2 * TILE_B); LAS unsigned char* Vt = Kt + TILE_B;
        *(LAS v4u*)(Kt + key * KP + ch * 16) = kreg; *(LAS v4u*)(Vt + key * KP + ch * 16) = vreg;
        __syncthreads();
        if (t + 1 < ntiles) { const int rbs = (t + 1 < 4) ? MLAT + b * CTXL + 64 * (t + 1) : b * SEQ + (krlo + t + 1 - 4) * 64; const bf16* p = kbase + (size_t)(rbs + key) * CIN; kreg = *(const v4u*)p; vreg = *(const v4u*)(p + DM); }
        if (t < 4) { attn_sub32(Kt, Vt, qf, st, lane, MfNone{}); attn_sub32(Kt + 32 * KP, Vt + 32 * KP, qf, st, lane, MfNone{}); }
        else { const int kr = krlo + t - 4;
            if ((kr >= r0a && kr < r0a + 8) || (kr >= r0b && kr < r0b + 8)) { int dr = kr - r + 7; dr = dr < 0 ? 0 : (dr > 14 ? 14 : dr);
                attn_sub32(Kt + kc0 * KP, Vt + kc0 * KP, qf, st, lane, MfNat{btab + dr * 31, c, qs, kc0, kr >= r0l && kr < r0l + 8}); } }
    }
    qt_store(st, AC + (size_t)qrow * DM + 64 * h, lane);
    __syncthreads();
}

__global__ void __launch_bounds__(NTHR, 2) mk_fwd(Args a) {
    extern __shared__ __attribute__((aligned(16))) unsigned char lds_raw[];
    LAS unsigned char* lds = (LAS unsigned char*)lds_raw;
    const int tid = threadIdx.x, lane = tid & 63, wave = __builtin_amdgcn_readfirstlane(tid >> 6);
    const int bid = blockIdx.x, G = gridDim.x;
    const int gw = bid * NWAVES + wave, NGW = G * NWAVES;
    const int lo = a.ph_lo, hi = a.ph_hi;
    unsigned char* ws = a.ws;
    const float* mod0 = (const float*)(ws + WS_MOD);
    const float* mod1 = mod0 + 9 * MODW;
    bf16* ACT = (bf16*)(ws + WS_ACT); bf16* BIG = (bf16*)(ws + WS_BIG);
    float* XRC = (float*)(ws + WS_XRC);
#define IN(k) (lo <= (k) && (k) < hi)
#define SEAM(k) do { if (IN(k) && IN((k) + 1)) { cg::this_grid().sync(); } } while (0)
#define GEMM_PHASE(EPI, Ap, Btp, M_, N_, K_, E) do { const pg8::Gemm g_{(const pg8::bf16_t*)(Ap), (const pg8::bf16_t*)(Btp), (M_), (N_), (K_)}; pg8::StaticOrder S_; S_.init((M_), (N_), G, bid); \
        pg8::gemm_phase<EPI, pg8::StaticOrder, true, true>(lds, g_, S_, (E)); } while (0)

    if (IN(0)) { ph0_prologue(a, lds, tid, lane, wave, bid, G); } SEAM(0);
    if (IN(1)) { ph1_modulate(a, lane, gw, NGW); } SEAM(1);
    if (IN(2)) { const pg8::EpiB16<pg8::FnIn0> E{BIG, ABIN, pg8::FnIn0{(const float*)(ws + WS_ROPE)}}; GEMM_PHASE(pg8::EpiB16<pg8::FnIn0>, ACT, ws + WS_WABIN, MALL, ABIN, DM, E); } SEAM(2);
    if (IN(3)) {
        for (int it = bid; it < 544; it += G) l0_attn_unit(a, lds, it, tid, lane, wave);
        for (int it = G - 1 - bid; it < MALL / 128; it += G) l0_gate_chunk_naive(a, lds, it, tid, lane, wave);
    } SEAM(3);
    if (IN(4)) { const pg8::EpiRes E{a.in[I_X], a.in[I_CTX], a.out, XRC, mod0 + 2 * DM}; GEMM_PHASE(pg8::EpiRes, ACT, ws + WS_WABOUT, MALL, DM, DM, E); } SEAM(4);
    if (IN(5)) { ph_layernorm(a, MALL, a.in[I_LN1G], a.in[I_LN1B], mod0 + 3 * DM, lane, gw, NGW); } SEAM(5);
    if (IN(6)) { const pg8::EpiB16<pg8::FnRelu2> E{BIG, FF, pg8::FnRelu2{}}; GEMM_PHASE(pg8::EpiB16<pg8::FnRelu2>, ACT, ws + WS_W1, MALL, FF, DM, E); } SEAM(6);
    if (IN(7)) { const pg8::EpiRes E{a.out, XRC, a.out, XRC, mod0 + 5 * DM}; GEMM_PHASE(pg8::EpiRes, BIG, ws + WS_W2, MALL, DM, FF, E); } SEAM(7);
    if (IN(8)) { ph_layernorm(a, MALL, a.in[I_LN2G], a.in[I_LN2B], mod1, lane, gw, NGW); } SEAM(8);
    if (IN(9)) { const pg8::EpiB16<pg8::FnIn1> E{BIG, CIN, pg8::FnIn1{}}; GEMM_PHASE(pg8::EpiB16<pg8::FnIn1>, ACT, ws + WS_WCIN, MALL, CIN, DM, E); } SEAM(9);
    if (IN(10)) { for (int it = bid; it < NBATCH * 16 * 16; it += G) l1_natten_unit(a, lds, it, tid, lane, wave); } SEAM(10);
    if (IN(11)) { const pg8::EpiRes E{a.out, XRC, a.out, XRC, mod1 + 2 * DM}; GEMM_PHASE(pg8::EpiRes, ACT, ws + WS_WCOUT, MLAT, DM, DM, E); } SEAM(11);
    if (IN(12)) { ph_layernorm(a, MLAT, a.in[I_LN1G] + DM, a.in[I_LN1B] + DM, mod1 + 3 * DM, lane, gw, NGW); } SEAM(12);
    if (IN(13)) { const pg8::EpiB16<pg8::FnRelu2> E{BIG, FF, pg8::FnRelu2{}}; GEMM_PHASE(pg8::EpiB16<pg8::FnRelu2>, ACT, ws + WS_W1 + 8 * MiB, MLAT, FF, DM, E); } SEAM(13);
    if (IN(14)) { const pg8::EpiRes E{a.out, XRC, a.out, XRC, mod1 + 5 * DM}; GEMM_PHASE(pg8::EpiRes, BIG, ws + WS_W2 + 8 * MiB, MLAT, DM, FF, E); } SEAM(14);
    if (IN(15)) { ph_layernorm(a, MLAT, a.in[I_LN2G] + DM, a.in[I_LN2B] + DM, nullptr, lane, gw, NGW); }
#undef IN
#undef SEAM
#undef GEMM_PHASE
}

extern "C" void kernel_launch(void* const* d_in, const int* in_sizes, int n_in, void* d_out, int out_size, void* d_ws, size_t ws_size, hipStream_t stream) {
    static int grid = 0;
    if (grid == 0) {
        if (n_in != 22 || in_sizes[0] != MLAT * DM || out_size != MLAT * DM || ws_size < WS_END) { fprintf(stderr, "kernel_launch: unexpected shapes (n_in %d, in0 %d, out %d, ws %zu)\n", n_in, n_in > 0 ? in_sizes[0] : -1, out_size, ws_size); grid = -1; return; }
        int dev = 0, cus = 0, per_cu = 0;
        if (hipGetDevice(&dev) != hipSuccess || hipDeviceGetAttribute(&cus, hipDeviceAttributeMultiprocessorCount, dev) != hipSuccess) { grid = -1; return; }
        if (hipFuncSetAttribute((const void*)mk_fwd, hipFuncAttributeMaxDynamicSharedMemorySize, LDS_BYTES) != hipSuccess) { fprintf(stderr, "kernel_launch: hipFuncSetAttribute failed\n"); grid = -1; return; }
        if (hipOccupancyMaxActiveBlocksPerMultiprocessor(&per_cu, (const void*)mk_fwd, NTHR, LDS_BYTES) != hipSuccess || per_cu < 1) { fprintf(stderr, "kernel_launch: occupancy query says %d blocks per CU\n", per_cu); per_cu = 1; }
        (void)hipGetLastError();
        grid = cus * (per_cu < 1 ? 1 : per_cu);
    }
    if (grid < 0) return;
    Args a{};
    for (int i = 0; i < 22; ++i) a.in[i] = (const float*)d_in[i];
    a.out = (float*)d_out; a.ws = (unsigned char*)d_ws;
    for (int i = 0; i < 16; ++i) a.freq[i] = powf(10000.0f, -(float)i / 16.0f);
    if (MK_N_LAUNCHES == 1) {
        a.ph_lo = 0; a.ph_hi = NPH;
        void* args[] = {&a};
        const hipError_t e = hipLaunchCooperativeKernel((const void*)mk_fwd, dim3(grid), dim3(NTHR), args, LDS_BYTES, stream);
        if (e != hipSuccess) fprintf(stderr, "kernel_launch: cooperative launch failed: %s (grid %d)\n", hipGetErrorString(e), grid);
    } else {
        for (int p = 0; p < NPH; ++p) { a.ph_lo = p; a.ph_hi = p + 1; hipLaunchKernelGGL(mk_fwd, dim3(grid), dim3(NTHR), LDS_BYTES, stream, a); }
    }
}
```

```cpp
#include <hip/hip_runtime.h>
#include <hip/hip_cooperative_groups.h>
#include <cstdio>
#include <cstdint>
namespace cg = cooperative_groups;

constexpr int DM = 1024, NBATCH = 8, SEQ = 4096, CTXL = 256;
constexpr int MLAT = NBATCH * SEQ;
constexpr int MCTX = NBATCH * CTXL;
constexpr int MALL = MLAT + MCTX;
constexpr int ABIN = 1792, CIN = 3072, FF = 4096, MODW = 6 * DM;
constexpr float LN_EPS = 1e-5f, ALPHA = 1.41421356237309515f;
namespace pg8 {
#define PG8_LAS __attribute__((address_space(3)))
typedef unsigned short bf16_t;
typedef short bf16x8 __attribute__((ext_vector_type(8)));
typedef float f32x4 __attribute__((ext_vector_type(4)));
typedef unsigned u32x4 __attribute__((ext_vector_type(4)));
constexpr int BM = 256, BK = 64, HALF = 128, HTB = HALF * BK * 2  , STAGE_BYTES = 8 * HTB, NXCD = 8, WGM = 8;

__host__ __device__ __forceinline__ int lds_byte(int r, int c) { const int st = (r >> 4) * 2 + (c >> 5), rr = r & 15, cc = c & 31, ob = rr * 64 + cc * 2; return st * 1024 + (ob ^ (((ob >> 9) & 1) << 5)); }
__host__ __device__ __forceinline__ void stage_rc(int b, int& R, int& C) { const int st = b / 1024, sb = b % 1024, swz = sb ^ (((sb >> 9) & 1) << 5); R = (st >> 1) * 16 + swz / 64; C = (st & 1) * 32 + (swz % 64) / 2; }
__host__ __device__ __forceinline__ int perm32(int rho) { const int n = rho >> 4, i = rho & 15; return 8 * (i >> 2) + 4 * n + (i & 3); }

struct Unit { int pm, pn; };
struct Gemm { const bf16_t* A; const bf16_t* Bt; int M, N, K; };

struct StaticOrder {
    int nM, nN, nwg, G, c;
    __host__ __device__ void init(int M, int N, int G_, int c_) { nM = M / BM; nN = N / BM; nwg = nM * nN; G = G_; c = c_; }
    __host__ __device__ bool next(int i, Unit& u) const {
        const long L = (long)i * G + c; if (L >= nwg) return false;
        int wgid = (int)L; { const int q = nwg / NXCD, r = nwg % NXCD, xcd = wgid % NXCD, off = wgid / NXCD; wgid = (xcd < r ? xcd * (q + 1) : r * (q + 1) + (xcd - r) * q) + off; }
        const int nig = WGM * nN, gid = wgid / nig, fm = gid * WGM, gsz = (nM - fm) < WGM ? (nM - fm) : WGM;
        u.pm = fm + ((wgid % nig) % gsz); u.pn = (wgid % nig) / gsz; return true;
    }
    __device__ __forceinline__ void a_ready(const Unit&) const {}
    __device__ __forceinline__ void done(const Unit&) const {}
};

__device__ __forceinline__ unsigned cvt_pk_bf16(float lo, float hi) { unsigned r; asm volatile("v_cvt_pk_bf16_f32 %0, %1, %2" : "=v"(r) : "v"(lo), "v"(hi)); return r; }
typedef float f32x2 __attribute__((ext_vector_type(2)));
__device__ __forceinline__ float bf2f(unsigned short h) { return __uint_as_float((unsigned)h << 16); }
__device__ __forceinline__ float bflo(unsigned u) { return __uint_as_float(u << 16); }
__device__ __forceinline__ float bfhi(unsigned u) { return __uint_as_float(u & 0xffff0000u); }

template <class Fn> struct EpiB16 {
    static constexpr bool PERM = true, AFTER_DRAIN = false;
    bf16_t* O; int ldc; Fn fn;
    __device__ __forceinline__ void operator()(const f32x4 (&acc)[2][2][4][2], const Unit& u, int wr, int wc, int fr, int fq) const {
        const int row0 = u.pm * BM + wr * 64 + fr, col0 = u.pn * BM + wc * 32 + 8 * fq;
#pragma unroll
        for (int ai = 0; ai < 2; ++ai)
#pragma unroll
            for (int m = 0; m < 4; ++m) { const int row = row0 + ai * HALF + m * 16;
#pragma unroll
                for (int bj = 0; bj < 2; ++bj) { const int col = col0 + bj * HALF;
                    float v[8];
#pragma unroll
                    for (int j = 0; j < 4; ++j) { v[j] = acc[ai][bj][m][0][j]; v[4 + j] = acc[ai][bj][m][1][j]; }
                    fn(row, col, v);
                    u32x4 w; w.x = cvt_pk_bf16(v[0], v[1]); w.y = cvt_pk_bf16(v[2], v[3]); w.z = cvt_pk_bf16(v[4], v[5]); w.w = cvt_pk_bf16(v[6], v[7]);
                    *(u32x4*)(O + (size_t)row * ldc + col) = w; } }
    }
};
struct FnIn0 {
    const float* rope;
    __device__ __forceinline__ void operator()(int row, int col, float (&v)[8]) const {
        if (col < 640) {
            if (row < MLAT) {
                const int s = row & (SEQ - 1), p0 = (col & 63) >> 1, pos = p0 < 16 ? (s >> 6) : (s & 63), f0 = p0 & 15;
                const f32x4* t = (const f32x4*)(rope + (pos * 16 + f0) * 2);
                const f32x4 t0 = t[0], t1 = t[1];
                const float c[4] = {t0[0], t0[2], t1[0], t1[2]}, sn[4] = {t0[1], t0[3], t1[1], t1[3]};
#pragma unroll
                for (int i = 0; i < 4; ++i) { const float x1 = v[2 * i], x2 = v[2 * i + 1]; v[2 * i] = x1 * c[i] - x2 * sn[i]; v[2 * i + 1] = x1 * sn[i] + x2 * c[i]; }
            }
            if (col < 512) {
#pragma unroll
                for (int j = 0; j < 8; ++j) v[j] *= 0.125f;
            }
        } else if (col >= 768) {
#pragma unroll
            for (int j = 0; j < 8; ++j) v[j] = 0.5f * v[j] * (1.0f + erff(v[j] * 0.70710678118654752f));
        }
    }
};
struct FnIn1 {
    __device__ __forceinline__ void operator()(int, int col, float (&v)[8]) const {
        if (col < DM) {
#pragma unroll
            for (int j = 0; j < 8; ++j) v[j] *= 0.125f;
        }
    }
};
struct FnRelu2 {
    __device__ __forceinline__ void operator()(int, int, float (&v)[8]) const {
#pragma unroll
        for (int j = 0; j < 8; ++j) { const float r = fmaxf(v[j], 0.f); v[j] = r * r; }
    }
};
struct EpiRes {
    static constexpr bool PERM = false, AFTER_DRAIN = false;
    const float* res_lat; const float* res_ctx; float* out_lat; float* out_ctx; const float* gate;
    __device__ __forceinline__ void operator()(const f32x4 (&acc)[2][2][4][2], const Unit& u, int wr, int wc, int fr, int fq) const {
        const int row0 = u.pm * BM + wr * 64 + fr, col0 = u.pn * BM + wc * 32 + 4 * fq;
        const int mr = u.pm < (MLAT / BM) ? (u.pm >> 4) : NBATCH;
        const float* g = gate + (size_t)mr * MODW;
        f32x4 gv[2][2];
#pragma unroll
        for (int bj = 0; bj < 2; ++bj)
#pragma unroll
            for (int n = 0; n < 2; ++n) gv[bj][n] = *(const f32x4*)(g + col0 + bj * HALF + n * 16);
#pragma unroll
        for (int ai = 0; ai < 2; ++ai)
#pragma unroll
            for (int m = 0; m < 4; ++m) { const int row = row0 + ai * HALF + m * 16;
                const float* rp; float* op;
                if (row < MLAT) { rp = res_lat + (size_t)row * DM; op = out_lat + (size_t)row * DM; } else { rp = res_ctx + (size_t)(row - MLAT) * DM; op = out_ctx + (size_t)(row - MLAT) * DM; }
#pragma unroll
                for (int bj = 0; bj < 2; ++bj)
#pragma unroll
                    for (int n = 0; n < 2; ++n) { const int c = col0 + bj * HALF + n * 16; const f32x4 x = *(const f32x4*)(rp + c);
                        *(f32x4*)(op + c) = x * ALPHA + gv[bj][n] * acc[ai][bj][m][n]; }
                if (m & 1) asm volatile("" ::: "memory"); }
    }
};

template <class Epi, class Sched, bool ALIGN_EPI = false, bool SP2 = false>
__device__ __forceinline__ void gemm_phase(PG8_LAS unsigned char* lds, const Gemm g, const Sched& S, const Epi& E) {
    const int tid = threadIdx.x, wid = __builtin_amdgcn_readfirstlane(tid >> 6), lane = tid & 63, wr = wid >> 2, wc = wid & 3, fr = lane & 15, fq = lane >> 4;
    const int K = g.K, nt = K / BK;
    unsigned voffA[2], voffB[2];
#pragma unroll
    for (int i = 0; i < 2; ++i) { int R, C; stage_rc(tid * 16 + i * 8192, R, C); const int Rb = Epi::PERM ? ((R & ~31) + perm32(R & 31)) : R;
        voffA[i] = (unsigned)(R * K + C) * 2u; voffB[i] = (unsigned)(Rb * K + C) * 2u; }
    const size_t kstep = (size_t)(BK * 2);
    const size_t hstep = (size_t)HALF * K * 2;
    const size_t tstep = 2 * hstep;
    const unsigned ldsw = (unsigned)wid * 1024u;
    const int aoff = lds_byte(wr * 64 + fr, fq * 8), boff = lds_byte(wc * 32 + fr, fq * 8);
#define PG8_SA(b, h) (((b) * 2 + (h)) * HTB)
#define PG8_SB(b, h) ((4 + (b) * 2 + (h)) * HTB)
#define PG8_STAGE(bufoff, gbase, voff) do { _Pragma("unroll") for (int _i = 0; _i < 2; ++_i) \
        __builtin_amdgcn_global_load_lds((const unsigned*)((const char*)(gbase) + (voff)[_i]), (PG8_LAS unsigned*)(lds + (bufoff) + ldsw + _i * 8192), 16, 0, 0); } while (0)
#define PG8_LDA(dst, b, h) do { _Pragma("unroll") for (int m = 0; m < 4; ++m) _Pragma("unroll") for (int k = 0; k < 2; ++k) dst[m][k] = *(const PG8_LAS bf16x8*)(lds + PG8_SA(b, h) + aoff + m * 2048 + k * 1024); } while (0)
#define PG8_LDB(dst, b, h) do { _Pragma("unroll") for (int n = 0; n < 2; ++n) _Pragma("unroll") for (int k = 0; k < 2; ++k) dst[n][k] = *(const PG8_LAS bf16x8*)(lds + PG8_SB(b, h) + boff + n * 2048 + k * 1024); } while (0)
#define PG8_MMA(ai, bj, At, Bt) do { __builtin_amdgcn_s_setprio(1); _Pragma("unroll") for (int m = 0; m < 4; ++m) _Pragma("unroll") for (int n = 0; n < 2; ++n) _Pragma("unroll") for (int k = 0; k < 2; ++k) \
        acc[ai][bj][m][n] = __builtin_amdgcn_mfma_f32_16x16x32_bf16(Bt[n][k], At[m][k], acc[ai][bj][m][n], 0, 0, 0); __builtin_amdgcn_s_setprio(0); } while (0)
#define PG8_WAIT_V(n) asm volatile("s_waitcnt vmcnt(" #n ")" ::: "memory")
#define PG8_WAIT_L(n) asm volatile("s_waitcnt lgkmcnt(" #n ")" ::: "memory")
#define PG8_BAR __builtin_amdgcn_s_barrier()
#define PG8_SCHED __builtin_amdgcn_sched_barrier(0)
    Unit cur, nxt; int ui = 0;
    if (!S.next(0, cur)) return;
    f32x4 acc[2][2][4][2];
#pragma unroll
    for (int a = 0; a < 2; ++a)
#pragma unroll
        for (int b = 0; b < 2; ++b)
#pragma unroll
            for (int m = 0; m < 4; ++m)
#pragma unroll
                for (int n = 0; n < 2; ++n) acc[a][b][m][n] = (f32x4){0.f, 0.f, 0.f, 0.f};
    bf16x8 At[4][2], B0[2][2], B1[2][2];
    const char* cA = (const char*)g.A + (size_t)cur.pm * tstep; const char* cB = (const char*)g.Bt + (size_t)cur.pn * tstep;
    S.a_ready(cur);
    if constexpr (SP2) {
        PG8_STAGE(PG8_SB(0, 0), cB, voffB); PG8_STAGE(PG8_SB(0, 1), cB + hstep, voffB); PG8_STAGE(PG8_SA(0, 0), cA, voffA); PG8_STAGE(PG8_SA(0, 1), cA + hstep, voffA);
        if (wr == 1) PG8_BAR;
        PG8_WAIT_V(2); PG8_BAR;
        PG8_STAGE(PG8_SB(1, 0), cB + kstep, voffB); PG8_STAGE(PG8_SA(1, 0), cA + kstep, voffA); PG8_STAGE(PG8_SB(1, 1), cB + hstep + kstep, voffB);
        PG8_WAIT_V(6); PG8_BAR;
    } else {
        PG8_STAGE(PG8_SB(0, 0), cB, voffB); PG8_STAGE(PG8_SA(0, 0), cA, voffA); PG8_STAGE(PG8_SB(0, 1), cB + hstep, voffB); PG8_STAGE(PG8_SA(0, 1), cA + hstep, voffA);
        if (wr == 1) PG8_BAR;
        PG8_WAIT_V(4); PG8_BAR;
        PG8_STAGE(PG8_SB(1, 0), cB + kstep, voffB); PG8_STAGE(PG8_SA(1, 0), cA + kstep, voffA); PG8_STAGE(PG8_SB(1, 1), cB + hstep + kstep, voffB);
        PG8_WAIT_V(6); PG8_BAR;
    }
    for (;;) {
        const bool has_next = S.next(ui + 1, nxt);
        const char* nA = has_next ? (const char*)g.A + (size_t)nxt.pm * tstep : cA; const char* nB = has_next ? (const char*)g.Bt + (size_t)nxt.pn * tstep : cB;
        for (int t = 0; t < nt; t += 2) {
            const bool last = (t == nt - 2);
            const char* a1 = cA + (size_t)(t + 1) * kstep;
            const char* a2 = last ? nA : cA + (size_t)(t + 2) * kstep; const char* b2 = last ? nB : cB + (size_t)(t + 2) * kstep;
            const char* a3 = a2 + kstep; const char* b3 = b2 + kstep;
            if (last && has_next) S.a_ready(nxt);
            if constexpr (SP2) {
            PG8_LDB(B0, 0, 0); PG8_LDB(B1, 0, 1); PG8_SCHED; PG8_LDA(At, 0, 0); PG8_STAGE(PG8_SA(1, 1), a1 + hstep, voffA);
            PG8_WAIT_V(8); PG8_WAIT_L(0); PG8_BAR; PG8_MMA(0, 0, At, B0); PG8_MMA(0, 1, At, B1); PG8_BAR; PG8_SCHED;
            PG8_LDA(At, 0, 1); PG8_STAGE(PG8_SB(0, 0), b2, voffB); PG8_STAGE(PG8_SB(0, 1), b2 + hstep, voffB); PG8_STAGE(PG8_SA(0, 0), a2, voffA);
            PG8_WAIT_V(8); PG8_WAIT_L(0); PG8_BAR; PG8_MMA(1, 0, At, B0); PG8_MMA(1, 1, At, B1); PG8_BAR; PG8_SCHED;
            PG8_LDB(B0, 1, 0); PG8_LDB(B1, 1, 1); PG8_SCHED; PG8_LDA(At, 1, 0); PG8_STAGE(PG8_SA(0, 1), a2 + hstep, voffA);
            PG8_WAIT_V(8); PG8_WAIT_L(0); PG8_BAR; PG8_MMA(0, 0, At, B0); PG8_MMA(0, 1, At, B1); PG8_BAR; PG8_SCHED;
            PG8_LDA(At, 1, 1); PG8_STAGE(PG8_SB(1, 0), b3, voffB); PG8_STAGE(PG8_SB(1, 1), b3 + hstep, voffB); PG8_STAGE(PG8_SA(1, 0), a3, voffA);
            PG8_WAIT_V(8); PG8_WAIT_L(0); PG8_BAR; PG8_MMA(1, 0, At, B0); PG8_MMA(1, 1, At, B1); PG8_BAR; PG8_SCHED;
            } else {
            PG8_LDB(B0, 0, 0); PG8_SCHED; PG8_LDA(At, 0, 0); PG8_STAGE(PG8_SA(1, 1), a1 + hstep, voffA);
            PG8_WAIT_L(8); PG8_BAR; PG8_WAIT_L(0); PG8_MMA(0, 0, At, B0); PG8_BAR; PG8_SCHED;
            PG8_LDB(B1, 0, 1); PG8_STAGE(PG8_SB(0, 0), b2, voffB);
            PG8_BAR; PG8_WAIT_L(0); PG8_MMA(0, 1, At, B1); PG8_BAR;
            PG8_LDA(At, 0, 1); PG8_STAGE(PG8_SA(0, 0), a2, voffA);
            PG8_BAR; PG8_WAIT_L(0); PG8_MMA(1, 0, At, B0); PG8_BAR; PG8_SCHED;
            PG8_STAGE(PG8_SB(0, 1), b2 + hstep, voffB);
            PG8_WAIT_V(6); PG8_BAR; PG8_MMA(1, 1, At, B1); PG8_BAR;
            PG8_LDB(B0, 1, 0); PG8_SCHED; PG8_LDA(At, 1, 0); PG8_STAGE(PG8_SA(0, 1), a2 + hstep, voffA);
            PG8_WAIT_L(8); PG8_BAR; PG8_WAIT_L(0); PG8_MMA(0, 0, At, B0); PG8_BAR; PG8_SCHED;
            PG8_LDB(B1, 1, 1); PG8_STAGE(PG8_SB(1, 0), b3, voffB);
            PG8_BAR; PG8_WAIT_L(0); PG8_MMA(0, 1, At, B1); PG8_BAR;
            PG8_LDA(At, 1, 1); PG8_STAGE(PG8_SA(1, 0), a3, voffA);
            PG8_BAR; PG8_WAIT_L(0); PG8_MMA(1, 0, At, B0); PG8_BAR; PG8_SCHED;
            PG8_STAGE(PG8_SB(1, 1), b3 + hstep, voffB);
            PG8_WAIT_V(6); PG8_BAR; PG8_MMA(1, 1, At, B1); PG8_BAR;
            }
        }
        if constexpr (ALIGN_EPI) { if (wr == 0) PG8_BAR; }
        if constexpr (!Epi::AFTER_DRAIN) { E(acc, cur, wr, wc, fr, fq); S.done(cur); }
        if (!has_next) break;
#pragma unroll
        for (int a = 0; a < 2; ++a)
#pragma unroll
            for (int b = 0; b < 2; ++b)
#pragma unroll
                for (int m = 0; m < 4; ++m)
#pragma unroll
                    for (int n = 0; n < 2; ++n) acc[a][b][m][n] = (f32x4){0.f, 0.f, 0.f, 0.f};
        cur = nxt; cA = nA; cB = nB; ++ui;
        if constexpr (ALIGN_EPI) { if (wr == 1) PG8_BAR; }
    }
    PG8_WAIT_V(0);
    if constexpr (!ALIGN_EPI) { if (wr == 0) PG8_BAR; }
    PG8_BAR;
    if constexpr (Epi::AFTER_DRAIN) { E.fused(acc, cur, wr, wc, fr, fq, lds, wid, lane); S.done(cur); }
#undef PG8_SA
#undef PG8_SB
#undef PG8_STAGE
#undef PG8_LDA
#undef PG8_LDB
#undef PG8_MMA
#undef PG8_WAIT_V
#undef PG8_WAIT_L
#undef PG8_BAR
#undef PG8_SCHED
}
}

#ifndef MK_N_LAUNCHES
#define MK_N_LAUNCHES 1
#endif
constexpr int NPH = 16;
constexpr int NWAVES = 8, NTHR = NWAVES * 64;
constexpr int LDS_BYTES = 147456;
#define LAS __attribute__((address_space(3)))
typedef unsigned short bf16;
typedef float f32x4 __attribute__((ext_vector_type(4)));
typedef unsigned v4u __attribute__((ext_vector_type(4)));
typedef unsigned v2u __attribute__((ext_vector_type(2)));
using pg8::bf2f; using pg8::bflo; using pg8::bfhi; using pg8::cvt_pk_bf16;

constexpr size_t MiB = 1u << 20;
constexpr size_t WS_CTL = 0, CTL_ZERO_BYTES = 1 * MiB;
constexpr size_t WS_MOD = 1 * MiB;
constexpr size_t WS_ROPE = 1 * MiB + 512 * 1024;
constexpr size_t WS_WABIN = 2 * MiB, WS_WABOUT = 6 * MiB, WS_WCIN = 8 * MiB, WS_WCOUT = 14 * MiB, WS_W1 = 16 * MiB, WS_W2 = 32 * MiB;
constexpr size_t WS_XRC = 48 * MiB;
constexpr size_t WS_ACT = 56 * MiB;
constexpr size_t WS_BIG = 128 * MiB;
constexpr size_t WS_END = 400 * MiB;
static_assert(WS_ACT + (size_t)MALL * DM * 2 <= WS_BIG && WS_BIG + (size_t)MALL * FF * 2 <= WS_END, "d_ws map");

struct Args { const float* in[22]; float* out; unsigned char* ws; float freq[16]; int ph_lo, ph_hi; };
enum { I_X = 0, I_C, I_CTX, I_CCTX, I_WMOD, I_BMOD, I_ABWIN, I_SINK, I_BLNG, I_BLNB, I_BWS, I_BBS, I_ABWOUT, I_CWIN, I_RPB, I_CWOUT, I_LN1G, I_LN1B, I_W1, I_W2, I_LN2G, I_LN2B };

__device__ __forceinline__ float wave_sum(float v) {
#pragma unroll
    for (int o = 1; o < 64; o <<= 1) v += __shfl_xor(v, o);
    return v;
}
__device__ __forceinline__ unsigned f2bf(float f) { unsigned u = __builtin_bit_cast(unsigned, f); return (u + 0x7fffu + ((u >> 16) & 1u)) >> 16; }
__device__ __forceinline__ unsigned pk2(float lo, float hi) { return f2bf(lo) | (f2bf(hi) << 16); }

__device__ __forceinline__ void sincos_d(double x, double& s, double& c) {
    const double kd = rint(x * 0.63661977236758134308); const int k = (int)kd;
    const double r = (x - kd * 1.57079632679489655800) - kd * 6.12323399573676603587e-17, r2 = r * r;
    const double sp = r * (1.0 + r2 * (-1.0 / 6.0 + r2 * (1.0 / 120.0 + r2 * (-1.0 / 5040.0 + r2 * (1.0 / 362880.0 + r2 * (-1.0 / 39916800.0 + r2 * (1.0 / 6227020800.0 + r2 * (-1.0 / 1307674368000.0))))))));
    const double cp = 1.0 + r2 * (-0.5 + r2 * (1.0 / 24.0 + r2 * (-1.0 / 720.0 + r2 * (1.0 / 40320.0 + r2 * (-1.0 / 3628800.0 + r2 * (1.0 / 479001600.0 + r2 * (-1.0 / 87178291200.0 + r2 * (1.0 / 20922789888000.0))))))));
    const int q = k & 3;
    s = q == 0 ? sp : q == 1 ? cp : q == 2 ? -sp : -cp;
    c = q == 0 ? cp : q == 1 ? -sp : q == 2 ? -cp : sp;
}

__device__ __forceinline__ void p0_transpose_item(const float* W, int K, int N, bf16* WT, LAS float* scr, int item, int lane) {
    const int nblk = N / 32, kb = item / nblk, nb = item % nblk, k0 = 64 * kb, n0 = 32 * nb;
#pragma unroll 8
    for (int i = 0; i < 32; ++i) { const int kk = 2 * i + (lane >> 5); scr[kk * 33 + (lane & 31)] = W[(size_t)(k0 + kk) * N + n0 + (lane & 31)]; }
    asm volatile("s_waitcnt lgkmcnt(0)" ::: "memory");
    const int c = lane & 7;
#pragma unroll
    for (int j = 0; j < 4; ++j) { const int n = (lane >> 3) + 8 * j; const LAS float* s = scr + (8 * c) * 33 + n;
        v4u o; o.x = pk2(s[0 * 33], s[1 * 33]); o.y = pk2(s[2 * 33], s[3 * 33]); o.z = pk2(s[4 * 33], s[5 * 33]); o.w = pk2(s[6 * 33], s[7 * 33]);
        *(v4u*)(WT + (size_t)(n0 + n) * K + k0 + 8 * c) = o; }
    asm volatile("s_waitcnt lgkmcnt(0)" ::: "memory");
}

__device__ __forceinline__ void p0_mod_item(const Args& a, LAS unsigned char* lds, int item, int tid, int lane, int wave) {
    LAS float* sc = (LAS float*)lds;
    LAS float* red = sc + 9 * DM;
    const int l = item / 96, strip = item % 96;
    const float* c = a.in[I_C]; const float* cc = a.in[I_CCTX];
    for (int i = tid; i < 9 * DM; i += NTHR) { const int r = i >> 10, k = i & (DM - 1); const float v = r < NBATCH ? c[r * DM + k] : cc[k]; sc[i] = v / (1.0f + expf(-v)); }
    __syncthreads();
    const float* w = a.in[I_WMOD] + (size_t)l * DM * MODW + strip * 64 + lane;
    float acc[9];
#pragma unroll
    for (int r = 0; r < 9; ++r) acc[r] = 0.f;
    const int k0 = wave * 128;
#pragma unroll 4
    for (int k = k0; k < k0 + 128; ++k) { const float wv = w[(size_t)k * MODW];
#pragma unroll
        for (int r = 0; r < 9; ++r) acc[r] = fmaf(sc[r * DM + k], wv, acc[r]); }
#pragma unroll
    for (int r = 0; r < 9; ++r) red[(wave * 9 + r) * 64 + lane] = acc[r];
    __syncthreads();
    float* mod = (float*)(a.ws + WS_MOD);
    for (int i = tid; i < 9 * 64; i += NTHR) { const int r = i >> 6, ln = i & 63; float s = 0.f;
#pragma unroll
        for (int wv = 0; wv < 8; ++wv) s += red[(wv * 9 + r) * 64 + ln];
        const int n = strip * 64 + ln; mod[(size_t)(l * 9 + r) * MODW + n] = s + a.in[I_BMOD][l * MODW + n]; }
    __syncthreads();
}

__device__ __forceinline__ void ph0_prologue(const Args& a, LAS unsigned char* lds, int tid, int lane, int wave, int bid, int G) {
    if (bid == G - 1) {
        float* rope = (float*)(a.ws + WS_ROPE);
        for (int i = tid; i < 64 * 16; i += NTHR) { const int pos = i >> 4, f = i & 15; const float ang = (float)pos * a.freq[f]; double s, c; sincos_d((double)ang, s, c); rope[2 * i] = (float)c; rope[2 * i + 1] = (float)s; }
    }
    for (int item = bid; item < 192; item += G) p0_mod_item(a, lds, item, tid, lane, wave);
    LAS float* scr = (LAS float*)(lds + wave * 16384);
    const int gw = bid * NWAVES + wave, NGW = G * NWAVES;
    { bf16* wsb = (bf16*)(a.ws + (1 * MiB + 768 * 1024)); const float* src = a.in[I_BWS];
      for (int i = (gw * 64 + lane) * 4; i < 8 * 128 * 128; i += NGW * 64 * 4) { const f32x4 v = *(const f32x4*)(src + i); v2u o; o.x = pk2(v[0], v[1]); o.y = pk2(v[2], v[3]); *(v2u*)(wsb + i) = o; } }
    constexpr int I_A = (DM / 64) * (ABIN / 32), I_O = (DM / 64) * (DM / 32), I_CI = (DM / 64) * (CIN / 32), I_U = (DM / 64) * (FF / 32), I_D = (FF / 64) * (DM / 32);
    constexpr int NITEMS = I_A + I_O + I_CI + I_O + 2 * I_U + 2 * I_D;
    unsigned char* ws = a.ws;
    for (int it = gw; it < NITEMS; it += NGW) {
        int r = it;
        if (r < I_A) { p0_transpose_item(a.in[I_ABWIN], DM, ABIN, (bf16*)(ws + WS_WABIN), scr, r, lane); continue; } r -= I_A;
        if (r < I_O) { p0_transpose_item(a.in[I_ABWOUT], DM, DM, (bf16*)(ws + WS_WABOUT), scr, r, lane); continue; } r -= I_O;
        if (r < I_CI) { p0_transpose_item(a.in[I_CWIN], DM, CIN, (bf16*)(ws + WS_WCIN), scr, r, lane); continue; } r -= I_CI;
        if (r < I_O) { p0_transpose_item(a.in[I_CWOUT], DM, DM, (bf16*)(ws + WS_WCOUT), scr, r, lane); continue; } r -= I_O;
        if (r < 2 * I_U) { const int l = r / I_U; p0_transpose_item(a.in[I_W1] + (size_t)l * DM * FF, DM, FF, (bf16*)(ws + WS_W1 + (size_t)l * 8 * MiB), scr, r % I_U, lane); continue; } r -= 2 * I_U;
        { const int l = r / I_D; p0_transpose_item(a.in[I_W2] + (size_t)l * DM * FF, FF, DM, (bf16*)(ws + WS_W2 + (size_t)l * 8 * MiB), scr, r % I_D, lane); }
    }
}

__device__ __forceinline__ float* xr_row(const Args& a, int row) { return row < MLAT ? a.out + (size_t)row * DM : (float*)(a.ws + WS_XRC) + (size_t)(row - MLAT) * DM; }
__device__ __forceinline__ int mod_row(int row) { return row < MLAT ? (row >> 12) : NBATCH; }

__device__ __forceinline__ void ph1_modulate(const Args& a, int lane, int gw, int NGW) {
    const float* mod0 = (const float*)(a.ws + WS_MOD);
    bf16* act = (bf16*)(a.ws + WS_ACT);
    for (int row = gw; row < MALL; row += NGW) {
        const float* src = row < MLAT ? a.in[I_X] + (size_t)row * DM : a.in[I_CTX] + (size_t)(row - MLAT) * DM;
        const float* mr = mod0 + (size_t)mod_row(row) * MODW;
#pragma unroll
        for (int j = 0; j < 4; ++j) { const int c = 4 * lane + 256 * j; const f32x4 v = *(const f32x4*)(src + c), sh = *(const f32x4*)(mr + c), sc = *(const f32x4*)(mr + DM + c);
            const f32x4 h = v * (sc + 1.0f) + sh; v2u o; o.x = pk2(h[0], h[1]); o.y = pk2(h[2], h[3]); *(v2u*)(act + (size_t)row * DM + c) = o; }
    }
}

__device__ __forceinline__ void ph_layernorm(const Args& a, int nrows, const float* gam, const float* bet, const float* modv, int lane, int gw, int NGW) {
    bf16* act = (bf16*)(a.ws + WS_ACT);
    for (int row = gw; row < nrows; row += NGW) {
        float* xr = xr_row(a, row);
        f32x4 v[4]; float s = 0.f;
#pragma unroll
        for (int j = 0; j < 4; ++j) { v[j] = *(const f32x4*)(xr + 4 * lane + 256 * j); s += (v[j][0] + v[j][1]) + (v[j][2] + v[j][3]); }
        const float mean = wave_sum(s) * (1.0f / DM); float s2 = 0.f;
#pragma unroll
        for (int j = 0; j < 4; ++j) { v[j] = v[j] - mean; s2 += (v[j][0] * v[j][0] + v[j][1] * v[j][1]) + (v[j][2] * v[j][2] + v[j][3] * v[j][3]); }
        const float rstd = 1.0f / sqrtf(wave_sum(s2) * (1.0f / DM) + LN_EPS);
#pragma unroll
        for (int j = 0; j < 4; ++j) { const int c = 4 * lane + 256 * j; const f32x4 y = v[j] * rstd * *(const f32x4*)(gam + c) + *(const f32x4*)(bet + c);
            *(f32x4*)(xr + c) = y;
            if (modv) { const float* mr = modv + (size_t)mod_row(row) * MODW; const f32x4 h = y * (*(const f32x4*)(mr + DM + c) + 1.0f) + *(const f32x4*)(mr + c);
                v2u o; o.x = pk2(h[0], h[1]); o.y = pk2(h[2], h[3]); *(v2u*)(act + (size_t)row * DM + c) = o; } }
    }
}

__device__ __forceinline__ void attn_key(const bf16* kp, const bf16* vp, bool valid, float bias, const float (&q)[64], float (&o)[64], float& m, float& l) {
    float dot = 0.f;
#pragma unroll
    for (int c = 0; c < 8; ++c) { const v4u kk = ((const v4u*)kp)[c];
        dot = fmaf(q[8 * c + 0], bflo(kk.x), dot); dot = fmaf(q[8 * c + 1], bfhi(kk.x), dot); dot = fmaf(q[8 * c + 2], bflo(kk.y), dot); dot = fmaf(q[8 * c + 3], bfhi(kk.y), dot);
        dot = fmaf(q[8 * c + 4], bflo(kk.z), dot); dot = fmaf(q[8 * c + 5], bfhi(kk.z), dot); dot = fmaf(q[8 * c + 6], bflo(kk.w), dot); dot = fmaf(q[8 * c + 7], bfhi(kk.w), dot); }
    const float sc = valid ? dot + bias : -1e30f;
    const float mn = fmaxf(m, sc), corr = __expf(m - mn), p = __expf(sc - mn);
    l = l * corr + p; m = mn;
#pragma unroll
    for (int c = 0; c < 8; ++c) { const v4u vv = ((const v4u*)vp)[c];
        o[8 * c + 0] = fmaf(o[8 * c + 0], corr, p * bflo(vv.x)); o[8 * c + 1] = fmaf(o[8 * c + 1], corr, p * bfhi(vv.x)); o[8 * c + 2] = fmaf(o[8 * c + 2], corr, p * bflo(vv.y)); o[8 * c + 3] = fmaf(o[8 * c + 3], corr, p * bfhi(vv.y));
        o[8 * c + 4] = fmaf(o[8 * c + 4], corr, p * bflo(vv.z)); o[8 * c + 5] = fmaf(o[8 * c + 5], corr, p * bfhi(vv.z)); o[8 * c + 6] = fmaf(o[8 * c + 6], corr, p * bflo(vv.w)); o[8 * c + 7] = fmaf(o[8 * c + 7], corr, p * bfhi(vv.w)); }
}
__device__ __forceinline__ void load_q64(const bf16* qp, float (&q)[64]) {
#pragma unroll
    for (int c = 0; c < 8; ++c) { const v4u t = ((const v4u*)qp)[c]; q[8 * c + 0] = bflo(t.x); q[8 * c + 1] = bfhi(t.x); q[8 * c + 2] = bflo(t.y); q[8 * c + 3] = bfhi(t.y); q[8 * c + 4] = bflo(t.z); q[8 * c + 5] = bfhi(t.z); q[8 * c + 6] = bflo(t.w); q[8 * c + 7] = bfhi(t.w); }
}
__device__ __forceinline__ void store_o64(bf16* op, const float (&o)[64], float inv) {
#pragma unroll
    for (int c = 0; c < 8; ++c) { v4u w; w.x = pk2(o[8 * c + 0] * inv, o[8 * c + 1] * inv); w.y = pk2(o[8 * c + 2] * inv, o[8 * c + 3] * inv); w.z = pk2(o[8 * c + 4] * inv, o[8 * c + 5] * inv); w.w = pk2(o[8 * c + 6] * inv, o[8 * c + 7] * inv); ((v4u*)op)[c] = w; }
}
__device__ __forceinline__ void l0_attn_item_naive(const Args& a, int item, int lane, int wave) {
    const bf16* Z = (const bf16*)(a.ws + WS_BIG); bf16* AB = (bf16*)(a.ws + WS_ACT);
    const int row = item * 64 + lane, h = wave, hkv = h >> 2;
    const bool latent = item < MLAT / 64;
    const int b = latent ? item >> 6 : (item - MLAT / 64) >> 2;
    float q[64], o[64];
    load_q64(Z + (size_t)row * ABIN + 64 * h, q);
#pragma unroll
    for (int d = 0; d < 64; ++d) o[d] = 0.f;
    float m = a.in[I_SINK][h], l = 1.0f;
    const bf16* kc = Z + (size_t)(MLAT + b * CTXL) * ABIN + 512 + 64 * hkv;
    for (int j = 0; j < CTXL; ++j) attn_key(kc + (size_t)j * ABIN, kc + (size_t)j * ABIN + 128, true, 0.f, q, o, m, l);
    if (latent) {
        const int s0 = (item & 63) * 64, s = s0 + lane, lo = s0 - 128 < 0 ? 0 : s0 - 128, hi = s0 + 191 > SEQ - 1 ? SEQ - 1 : s0 + 191;
        const bf16* kl = Z + (size_t)(b * SEQ) * ABIN + 512 + 64 * hkv;
        for (int kp = lo; kp <= hi; ++kp) { const int d = s - kp; attn_key(kl + (size_t)kp * ABIN, kl + (size_t)kp * ABIN + 128, d <= 128 && d >= -128, 0.f, q, o, m, l); }
    }
    store_o64(AB + (size_t)row * DM + 64 * h, o, 1.0f / l);
}
__device__ __forceinline__ void l0_gate_chunk_naive(const Args& a, LAS unsigned char* lds, int chunk, int tid, int lane, int wave) {
    const bf16* Z = (const bf16*)(a.ws + WS_BIG); bf16* AB = (bf16*)(a.ws + WS_ACT);
    LAS float* st = (LAS float*)lds;
    LAS float* vn = st + 256;
    const int base = chunk * 128;
    for (int i = 0; i < 16; ++i) { const int r = wave * 16 + i; const v4u t = *(const v4u*)(Z + (size_t)(base + r) * ABIN + 1280 + lane * 8);
        float x[8] = {bflo(t.x), bfhi(t.x), bflo(t.y), bfhi(t.y), bflo(t.z), bfhi(t.z), bflo(t.w), bfhi(t.w)}; float s = 0.f;
#pragma unroll
        for (int j = 0; j < 8; ++j) s += x[j];
        const float mean = wave_sum(s) * (1.0f / 512.0f); float s2 = 0.f;
#pragma unroll
        for (int j = 0; j < 8; ++j) { const float d = x[j] - mean; s2 += d * d; }
        const float var = wave_sum(s2) * (1.0f / 512.0f);
        if (lane == 0) { st[2 * r] = mean; st[2 * r + 1] = 1.0f / sqrtf(var + LN_EPS); } }
    __syncthreads();
    const float* wsg = a.in[I_BWS]; const float* bs = a.in[I_BBS];
    for (int g = 0; g < 8; ++g) {
        { const int c = tid & 63; const float lg = a.in[I_BLNG][g * 64 + c], lb = a.in[I_BLNB][g * 64 + c];
          for (int i = 0; i < 16; ++i) { const int qq = (tid >> 6) + 8 * i; const float x = bf2f(Z[(size_t)(base + qq) * ABIN + 1280 + g * 64 + c]); vn[qq * 64 + c] = (x - st[2 * qq]) * st[2 * qq + 1] * lg + lb; } }
        __syncthreads();
        float acc[16];
#pragma unroll
        for (int j = 0; j < 16; ++j) acc[j] = 0.f;
        const float* wrow = wsg + (size_t)(g * 128 + wave * 16) * 128;
        for (int qq = 0; qq < 128; ++qq) { const float v = vn[qq * 64 + lane];
#pragma unroll
            for (int j = 0; j < 16; ++j) acc[j] = fmaf(wrow[j * 128 + qq], v, acc[j]); }
#pragma unroll
        for (int j = 0; j < 16; ++j) { const int p = wave * 16 + j; const size_t row = (size_t)(base + p); const float mixed = acc[j] + bs[g * 128 + p]; const float u = bf2f(Z[row * ABIN + 768 + g * 64 + lane]);
            AB[row * DM + 512 + g * 64 + lane] = (bf16)f2bf(u * mixed); }
        __syncthreads();
    }
}
__device__ __forceinline__ void l1_natten_item_naive(const Args& a, int item, int lane, int wave) {
    const bf16* Z = (const bf16*)(a.ws + WS_BIG); bf16* AC = (bf16*)(a.ws + WS_ACT);
    const int rg = item >> 1, h = (item & 1) * 8 + wave, row = rg * 64 + lane, b = rg >> 6, r = rg & 63, c = lane;
    const int r0 = r - 4 < 0 ? 0 : (r - 4 > 56 ? 56 : r - 4), qs = c - 8 < 0 ? 0 : (c - 8 > 48 ? 48 : c - 8);
    float q[64], o[64];
    load_q64(Z + (size_t)row * CIN + 64 * h, q);
#pragma unroll
    for (int d = 0; d < 64; ++d) o[d] = 0.f;
    float m = -1e30f, l = 0.f;
    const bf16* kc = Z + (size_t)(MLAT + b * CTXL) * CIN + DM + 64 * h;
    for (int j = 0; j < CTXL; ++j) attn_key(kc + (size_t)j * CIN, kc + (size_t)j * CIN + DM, true, 0.f, q, o, m, l);
    const float* rpb = a.in[I_RPB] + h * 465;
    for (int kr = r0; kr < r0 + 8; ++kr) {
        const bf16* kl = Z + (size_t)(b * SEQ + kr * 64) * CIN + DM + 64 * h; const float* brow = rpb + (kr - r + 7) * 31;
        for (int kcx = 0; kcx < 64; ++kcx) { int dc = kcx - c + 15; dc = dc < 0 ? 0 : (dc > 30 ? 30 : dc);
            attn_key(kl + (size_t)kcx * CIN, kl + (size_t)kcx * CIN + DM, kcx >= qs && kcx < qs + 16, brow[dc], q, o, m, l); }
    }
    store_o64(AC + (size_t)row * DM + 64 * h, o, 1.0f / l);
}


typedef float f32x16 __attribute__((ext_vector_type(16)));
typedef short bf16x8 __attribute__((ext_vector_type(8)));
typedef short s16x4 __attribute__((ext_vector_type(4)));
constexpr int KP = 144;
constexpr int TILE_B = 64 * KP;
constexpr float LOG2E = 1.4426950408889634f;
__device__ __forceinline__ int crow(int r, int hi) { return (r & 3) + 8 * (r >> 2) + 4 * hi; }
__device__ __forceinline__ s16x4 tr_read(const LAS unsigned char* p) { return __builtin_bit_cast(s16x4, __builtin_amdgcn_ds_read_tr16_b64_v4i16((LAS s16x4*)p)); }
struct QT { f32x16 o0, o1; float m, l; };
struct MfNone { __device__ __forceinline__ float operator()(float s, int, int) const { return s * LOG2E; } };
struct MfWin { int dq;
    __device__ __forceinline__ float operator()(float s, int r, int hi) const { const int d = dq - crow(r, hi); return (d > 128 || d < -128) ? -1e30f : s * LOG2E; } };
struct MfNat { const LAS float* brow; int cq, qs, kc0; bool rowok;
    __device__ __forceinline__ float operator()(float s, int r, int hi) const { const int kc = kc0 + crow(r, hi); int dc = kc - cq + 15; dc = dc < 0 ? 0 : (dc > 30 ? 30 : dc);
        const bool ok = rowok && kc >= qs && kc < qs + 16; return ok ? (s + brow[dc]) * LOG2E : -1e30f; } };
template <class MF> __device__ __forceinline__ void attn_sub32(const LAS unsigned char* Ks, const LAS unsigned char* Vs, const bf16x8 (&qf)[4], QT& st, int lane, const MF& mf) {
    const int r32 = lane & 31, hi = lane >> 5;
    f32x16 s;
#pragma unroll
    for (int r = 0; r < 16; ++r) s[r] = 0.f;
    const LAS unsigned char* kp = Ks + r32 * KP + hi * 16;
#pragma unroll
    for (int ks = 0; ks < 4; ++ks) { const bf16x8 kf = *(const LAS bf16x8*)(kp + ks * 32); s = __builtin_amdgcn_mfma_f32_32x32x16_bf16(kf, qf[ks], s, 0, 0, 0); }
    float mx = -1e30f;
#pragma unroll
    for (int r = 0; r < 16; ++r) { const float t = mf(s[r], r, hi); s[r] = t; mx = fmaxf(mx, t); }
    mx = fmaxf(mx, __shfl_xor(mx, 32));
    const float mn = fmaxf(st.m, mx), corr = __builtin_amdgcn_exp2f(st.m - mn);
    st.m = mn; st.l *= corr; st.o0 = st.o0 * corr; st.o1 = st.o1 * corr;
    float ps = 0.f;
#pragma unroll
    for (int r = 0; r < 16; ++r) { const float p = __builtin_amdgcn_exp2f(s[r] - mn); s[r] = p; ps += p; }
    st.l += ps;
    const int g = lane >> 4, i = lane & 15;
    const LAS unsigned char* vp = Vs + (4 * (g >> 1) + (i >> 2)) * KP + (16 * (g & 1) + 4 * (i & 3)) * 2;
#pragma unroll
    for (int sp = 0; sp < 2; ++sp) {
        v4u pw; pw.x = cvt_pk_bf16(s[8 * sp + 0], s[8 * sp + 1]); pw.y = cvt_pk_bf16(s[8 * sp + 2], s[8 * sp + 3]); pw.z = cvt_pk_bf16(s[8 * sp + 4], s[8 * sp + 5]); pw.w = cvt_pk_bf16(s[8 * sp + 6], s[8 * sp + 7]);
        const bf16x8 pf = __builtin_bit_cast(bf16x8, pw);
        { const s16x4 lo = tr_read(vp + (16 * sp) * KP), hi4 = tr_read(vp + (16 * sp + 8) * KP); const bf16x8 vf = {lo[0], lo[1], lo[2], lo[3], hi4[0], hi4[1], hi4[2], hi4[3]};
          st.o0 = __builtin_amdgcn_mfma_f32_32x32x16_bf16(vf, pf, st.o0, 0, 0, 0); }
        { const s16x4 lo = tr_read(vp + (16 * sp) * KP + 64), hi4 = tr_read(vp + (16 * sp + 8) * KP + 64); const bf16x8 vf = {lo[0], lo[1], lo[2], lo[3], hi4[0], hi4[1], hi4[2], hi4[3]};
          st.o1 = __builtin_amdgcn_mfma_f32_32x32x16_bf16(vf, pf, st.o1, 0, 0, 0); }
    }
}
__device__ __forceinline__ void qt_init(QT& st, float m0, float l0) {
#pragma unroll
    for (int r = 0; r < 16; ++r) { st.o0[r] = 0.f; st.o1[r] = 0.f; }
    st.m = m0; st.l = l0;
}
__device__ __forceinline__ void qt_store(const QT& st, bf16* orow, int lane) {
    const int hi = lane >> 5; const float lt = st.l + __shfl_xor(st.l, 32), inv = 1.0f / lt;
#pragma unroll
    for (int gq = 0; gq < 4; ++gq) {
        v2u w0; w0.x = cvt_pk_bf16(st.o0[4 * gq + 0] * inv, st.o0[4 * gq + 1] * inv); w0.y = cvt_pk_bf16(st.o0[4 * gq + 2] * inv, st.o0[4 * gq + 3] * inv); *(v2u*)(orow + 8 * gq + 4 * hi) = w0;
        v2u w1; w1.x = cvt_pk_bf16(st.o1[4 * gq + 0] * inv, st.o1[4 * gq + 1] * inv); w1.y = cvt_pk_bf16(st.o1[4 * gq + 2] * inv, st.o1[4 * gq + 3] * inv); *(v2u*)(orow + 32 + 8 * gq + 4 * hi) = w1; }
}
__device__ __forceinline__ void l0_attn_unit(const Args& a, LAS unsigned char* lds, int unit, int tid, int lane, int wave) {
    const bf16* Z = (const bf16*)(a.ws + WS_BIG); bf16* AB = (bf16*)(a.ws + WS_ACT);
    const bool latent = unit < 512;
    int b, hkv, qb; if (latent) { b = unit >> 6; hkv = (unit >> 5) & 1; qb = unit & 31; } else { const int u2 = unit - 512; b = u2 >> 2; hkv = (u2 >> 1) & 1; qb = u2 & 1; }
    const int qrow0 = latent ? b * SEQ + qb * 128 : MLAT + b * CTXL + qb * 128;
    const int h = hkv * 4 + (wave >> 1), qw = 64 * (wave & 1), r32 = lane & 31, hi = lane >> 5;
    bf16x8 qf[2][4]; QT st[2];
#pragma unroll
    for (int qt = 0; qt < 2; ++qt) { const bf16* qp = Z + (size_t)(qrow0 + qw + 32 * qt + r32) * ABIN + 64 * h + 8 * hi;
#pragma unroll
        for (int ks = 0; ks < 4; ++ks) qf[qt][ks] = *(const bf16x8*)(qp + 16 * ks);
        qt_init(st[qt], a.in[I_SINK][h] * LOG2E, hi == 0 ? 1.0f : 0.0f); }
    const int s0 = qb * 128; int klo = 0, nloc = 0;
    if (latent) { klo = s0 - 128 < 0 ? 0 : s0 - 128; const int khi = s0 + 256 > SEQ ? SEQ : s0 + 256; nloc = (khi - klo) >> 6; }
    const int ntiles = 4 + nloc, key = tid >> 3, ch = tid & 7;
    const bf16* kbase = Z + 512 + 64 * hkv + 8 * ch;
    v4u kreg, vreg;
    { const bf16* p = kbase + (size_t)(MLAT + b * CTXL + key) * ABIN; kreg = *(const v4u*)p; vreg = *(const v4u*)(p + 128); }
    for (int t = 0; t < ntiles; ++t) {
        LAS unsigned char* Kt = lds + (t & 1) * (2 * TILE_B); LAS unsigned char* Vt = Kt + TILE_B;
        *(LAS v4u*)(Kt + key * KP + ch * 16) = kreg; *(LAS v4u*)(Vt + key * KP + ch * 16) = vreg;
        __syncthreads();
        if (t + 1 < ntiles) { const int rb = (t + 1 < 4) ? MLAT + b * CTXL + 64 * (t + 1) : b * SEQ + klo + 64 * (t + 1 - 4); const bf16* p = kbase + (size_t)(rb + key) * ABIN; kreg = *(const v4u*)p; vreg = *(const v4u*)(p + 128); }
#pragma unroll
        for (int qt = 0; qt < 2; ++qt)
#pragma unroll 1
            for (int sub = 0; sub < 2; ++sub) {
                const LAS unsigned char* Ks = Kt + 32 * sub * KP; const LAS unsigned char* Vs = Vt + 32 * sub * KP;
                if (t < 4) attn_sub32(Ks, Vs, qf[qt], st[qt], lane, MfNone{});
                else { const int sq0 = s0 + qw + 32 * qt, kp0 = klo + 64 * (t - 4) + 32 * sub;
                    if (kp0 - (sq0 + 31) > 128 || sq0 - (kp0 + 31) > 128) continue;
                    if ((sq0 + 31) - kp0 <= 128 && (kp0 + 31) - sq0 <= 128) attn_sub32(Ks, Vs, qf[qt], st[qt], lane, MfNone{});
                    else attn_sub32(Ks, Vs, qf[qt], st[qt], lane, MfWin{sq0 + r32 - kp0}); }
            }
    }
#pragma unroll
    for (int qt = 0; qt < 2; ++qt) qt_store(st[qt], AB + (size_t)(qrow0 + qw + 32 * qt + r32) * DM + 64 * h, lane);
    __syncthreads();
}
__device__ __forceinline__ void l1_natten_unit(const Args& a, LAS unsigned char* lds, int unit, int tid, int lane, int wave) {
    const bf16* Z = (const bf16*)(a.ws + WS_BIG); bf16* AC = (bf16*)(a.ws + WS_ACT);
    const int r4 = (unit & 15) * 4, h = (unit >> 4) & 15, b = unit >> 8;
    LAS float* btab = (LAS float*)(lds + 4 * TILE_B);
    for (int i = tid; i < 465; i += NTHR) btab[i] = a.in[I_RPB][h * 465 + i];
    const int rp = wave >> 2, j = wave & 3, r32 = lane & 31, hi = lane >> 5;
    const int r = r4 + 2 * rp + ((lane >> 4) & 1), c = 16 * j + (lane & 15), qrow = b * SEQ + r * 64 + c;
    const int r0l = r - 4 < 0 ? 0 : (r - 4 > 56 ? 56 : r - 4), qs = c - 8 < 0 ? 0 : (c - 8 > 48 ? 48 : c - 8);
    const int kc0 = 16 * j - 8 < 0 ? 0 : (16 * j - 8 > 32 ? 32 : 16 * j - 8);
    const int ra = r4 + 2 * rp, rb = ra + 1;
    const int r0a = ra - 4 < 0 ? 0 : (ra - 4 > 56 ? 56 : ra - 4), r0b = rb - 4 < 0 ? 0 : (rb - 4 > 56 ? 56 : rb - 4);
    bf16x8 qf[4]; QT st;
    { const bf16* qp = Z + (size_t)qrow * CIN + 64 * h + 8 * hi;
#pragma unroll
      for (int ks = 0; ks < 4; ++ks) qf[ks] = *(const bf16x8*)(qp + 16 * ks); }
    qt_init(st, -1e30f, 0.f);
    const int krlo = r4 - 4 < 0 ? 0 : (r4 - 4 > 56 ? 56 : r4 - 4); const int krhi = (r4 - 1 < 0 ? 0 : (r4 - 1 > 56 ? 56 : r4 - 1)) + 8;
    const int ntiles = 4 + (krhi - krlo), key = tid >> 3, ch = tid & 7;
    const bf16* kbase = Z + DM + 64 * h + 8 * ch;
    v4u kreg, vreg;
    { const bf16* p = kbase + (size_t)(MLAT + b * CTXL + key) * CIN; kreg = *(const v4u*)p; vreg = *(const v4u*)(p + DM); }
    for (int t = 0; t < ntiles; ++t) {
        LAS unsigned char* Kt = lds + (t & 1) * (2 * TILE_B); LAS unsigned char* Vt = Kt + TILE_B;
        *(LAS v4u*)(Kt + key * KP + ch * 16) = kreg; *(LAS v4u*)(Vt + key * KP + ch * 16) = vreg;
        __syncthreads();
        if (t + 1 < ntiles) { const int rbs = (t + 1 < 4) ? MLAT + b * CTXL + 64 * (t + 1) : b * SEQ + (krlo + t + 1 - 4) * 64; const bf16* p = kbase + (size_t)(rbs + key) * CIN; kreg = *(const v4u*)p; vreg = *(const v4u*)(p + DM); }
        if (t < 4) { attn_sub32(Kt, Vt, qf, st, lane, MfNone{}); attn_sub32(Kt + 32 * KP, Vt + 32 * KP, qf, st, lane, MfNone{}); }
        else { const int kr = krlo + t - 4;
            if ((kr >= r0a && kr < r0a + 8) || (kr >= r0b && kr < r0b + 8)) { int dr = kr - r + 7; dr = dr < 0 ? 0 : (dr > 14 ? 14 : dr);
                attn_sub32(Kt + kc0 * KP, Vt + kc0 * KP, qf, st, lane, MfNat{btab + dr * 31, c, qs, kc0, kr >= r0l && kr < r0l + 8}); } }
    }
    qt_store(st, AC + (size_t)qrow * DM + 64 * h, lane);
    __syncthreads();
}


constexpr int VNP = 136;
constexpr size_t WS_WSB = 1 * MiB + 768 * 1024;
__device__ __forceinline__ void l0_gate_chunk(const Args& a, LAS unsigned char* lds, int chunk, int tid, int lane, int wave) {
    const bf16* Z = (const bf16*)(a.ws + WS_BIG); bf16* AB = (bf16*)(a.ws + WS_ACT);
    LAS float* st = (LAS float*)(lds + 8 * 128 * VNP);
    LAS unsigned char* vn = lds + wave * (128 * VNP);
    const int base = chunk * 128, g = wave;
    for (int i = 0; i < 16; ++i) { const int r = wave * 16 + i; const v4u t = *(const v4u*)(Z + (size_t)(base + r) * ABIN + 1280 + lane * 8);
        float x[8] = {bflo(t.x), bfhi(t.x), bflo(t.y), bfhi(t.y), bflo(t.z), bfhi(t.z), bflo(t.w), bfhi(t.w)}; float s = 0.f;
#pragma unroll
        for (int j = 0; j < 8; ++j) s += x[j];
        const float mean = wave_sum(s) * (1.0f / 512.0f); float s2 = 0.f;
#pragma unroll
        for (int j = 0; j < 8; ++j) { const float d = x[j] - mean; s2 += d * d; }
        const float var = wave_sum(s2) * (1.0f / 512.0f);
        if (lane == 0) { st[2 * r] = mean; st[2 * r + 1] = 1.0f / sqrtf(var + LN_EPS); } }
    __syncthreads();
    { const int ch = lane & 7, c0 = 64 * g + 8 * ch; float lg[8], lb[8];
#pragma unroll
      for (int j = 0; j < 8; ++j) { lg[j] = a.in[I_BLNG][c0 + j]; lb[j] = a.in[I_BLNB][c0 + j]; }
#pragma unroll 4
      for (int i = 0; i < 16; ++i) { const int q = i * 8 + (lane >> 3); const v4u t = *(const v4u*)(Z + (size_t)(base + q) * ABIN + 1280 + c0);
          const float mean = st[2 * q], rstd = st[2 * q + 1];
          float x[8] = {bflo(t.x), bfhi(t.x), bflo(t.y), bfhi(t.y), bflo(t.z), bfhi(t.z), bflo(t.w), bfhi(t.w)};
#pragma unroll
          for (int j = 0; j < 8; ++j) x[j] = (x[j] - mean) * rstd * lg[j] + lb[j];
          v2u w0, w1; w0.x = cvt_pk_bf16(x[0], x[1]); w0.y = cvt_pk_bf16(x[2], x[3]); w1.x = cvt_pk_bf16(x[4], x[5]); w1.y = cvt_pk_bf16(x[6], x[7]);
          *(LAS v2u*)(vn + q * VNP + ch * 16) = w0; *(LAS v2u*)(vn + q * VNP + ch * 16 + 8) = w1; } }
    asm volatile("s_waitcnt lgkmcnt(0)" ::: "memory");
    const int r32 = lane & 31, hi = lane >> 5, g4 = lane >> 4, i15 = lane & 15;
    const LAS unsigned char* vp = vn + (8 * (g4 >> 1) + (i15 >> 2)) * VNP + (16 * (g4 & 1) + 4 * (i15 & 3)) * 2;
    const bf16* wsb = (const bf16*)(a.ws + WS_WSB) + (size_t)g * 128 * 128;
    const float* bs = a.in[I_BBS] + g * 128;
#pragma unroll 1
    for (int pt = 0; pt < 4; ++pt) {
        f32x16 acc0, acc1;
#pragma unroll
        for (int r = 0; r < 16; ++r) { acc0[r] = 0.f; acc1[r] = 0.f; }
        const bf16* wp = wsb + (size_t)(32 * pt + r32) * 128 + 8 * hi;
#pragma unroll
        for (int ks = 0; ks < 8; ++ks) { const bf16x8 wf = *(const bf16x8*)(wp + 16 * ks);
            { const s16x4 lo = tr_read(vp + (16 * ks) * VNP), h4 = tr_read(vp + (16 * ks + 4) * VNP); const bf16x8 vf = {lo[0], lo[1], lo[2], lo[3], h4[0], h4[1], h4[2], h4[3]};
              acc0 = __builtin_amdgcn_mfma_f32_32x32x16_bf16(vf, wf, acc0, 0, 0, 0); }
            { const s16x4 lo = tr_read(vp + (16 * ks) * VNP + 64), h4 = tr_read(vp + (16 * ks + 4) * VNP + 64); const bf16x8 vf = {lo[0], lo[1], lo[2], lo[3], h4[0], h4[1], h4[2], h4[3]};
              acc1 = __builtin_amdgcn_mfma_f32_32x32x16_bf16(vf, wf, acc1, 0, 0, 0); } }
        const int p = 32 * pt + r32; const size_t row = (size_t)(base + p); const float bsp = bs[p];
        const bf16* up = Z + row * ABIN + 768 + 64 * g + 4 * hi; bf16* op = AB + row * DM + 512 + 64 * g + 4 * hi;
#pragma unroll
        for (int gq = 0; gq < 4; ++gq) {
            { const v2u u = *(const v2u*)(up + 8 * gq); v2u w; w.x = cvt_pk_bf16(bflo(u.x) * (acc0[4 * gq + 0] + bsp), bfhi(u.x) * (acc0[4 * gq + 1] + bsp)); w.y = cvt_pk_bf16(bflo(u.y) * (acc0[4 * gq + 2] + bsp), bfhi(u.y) * (acc0[4 * gq + 3] + bsp)); *(v2u*)(op + 8 * gq) = w; }
            { const v2u u = *(const v2u*)(up + 32 + 8 * gq); v2u w; w.x = cvt_pk_bf16(bflo(u.x) * (acc1[4 * gq + 0] + bsp), bfhi(u.x) * (acc1[4 * gq + 1] + bsp)); w.y = cvt_pk_bf16(bflo(u.y) * (acc1[4 * gq + 2] + bsp), bfhi(u.y) * (acc1[4 * gq + 3] + bsp)); *(v2u*)(op + 32 + 8 * gq) = w; } }
    }
    __syncthreads();
}


#define XB_TMO      128
#define XB_XCNT(j)  (256  + 64 * (j))
#define XB_XSUB(j)  (1280 + 64 * (j))
#define XB_XGEN(j)  (2304 + 64 * (j))
#define XB_TOP      3328
#define XB_TOPGEN   3392
#define XCD_BAR_WORDS 3456
#define XB_SPIN_CAP (1u << 18)
__device__ __forceinline__ unsigned xb_ld(unsigned* p)              { return __hip_atomic_load(p, __ATOMIC_RELAXED, __HIP_MEMORY_SCOPE_AGENT); }
__device__ __forceinline__ unsigned xb_add(unsigned* p, unsigned v) { return __hip_atomic_fetch_add(p, v, __ATOMIC_RELAXED, __HIP_MEMORY_SCOPE_AGENT); }
__device__ __forceinline__ unsigned xb_xcc_id() { return (unsigned)__builtin_amdgcn_s_getreg((3 << 11) | 20) & 0xFu; }
#define XB_SPIN(cond, bar) do { unsigned _sp = 0; while (cond) { __builtin_amdgcn_s_sleep(1); \
    if ((++_sp & 255u) == 0u) { if (xb_ld(&(bar)[XB_TMO])) break; if (_sp > XB_SPIN_CAP) { atomicAdd(&(bar)[XB_TMO], 1u); break; } } } } while (0)
struct XcdBarrier { unsigned* bar; unsigned x; volatile LAS unsigned* st; };
__device__ __forceinline__ XcdBarrier xcd_barrier_post(unsigned* bar, volatile LAS unsigned* st) {
    XcdBarrier b; b.bar = bar; b.x = xb_xcc_id(); b.st = st;
    if (threadIdx.x == 0) (void)xb_add(&bar[XB_XCNT(b.x)], 1u);
    return b;
}
__device__ __forceinline__ void xcd_barrier_complete(unsigned* bar, unsigned x, unsigned& nloc, unsigned& nx) {
    const unsigned G = gridDim.x * gridDim.y * gridDim.z;
    unsigned sum, cnt, mine, sp = 0u;
    for (;;) {
        sum = 0u; cnt = 0u; mine = 0u;
#pragma unroll
        for (unsigned j = 0; j < 16; ++j) { const unsigned c = xb_ld(&bar[XB_XCNT(j)]); sum += c; cnt += (c > 0u) ? 1u : 0u; mine = (j == x) ? c : mine; }
        if (sum == G) break;
        __builtin_amdgcn_s_sleep(1);
        if ((++sp & 255u) == 0u) { if (xb_ld(&bar[XB_TMO])) break; if (sp > XB_SPIN_CAP) { atomicAdd(&bar[XB_TMO], 1u); break; } }
    }
    nloc = mine > 0u ? mine : 1u; nx = cnt > 0u ? cnt : 1u;
}
__device__ __forceinline__ void xcd_barrier(const XcdBarrier& b) {
    asm volatile("s_waitcnt vmcnt(0)" ::: "memory");
    __syncthreads();
    if (threadIdx.x == 0) {
        unsigned* bar = b.bar;
        __builtin_amdgcn_s_waitcnt(0);
        unsigned nloc = b.st[0], nx = b.st[1];
        if (nloc == 0u) { xcd_barrier_complete(bar, b.x, nloc, nx); b.st[0] = nloc; b.st[1] = nx; }
        const unsigned old = xb_add(&bar[XB_XSUB(b.x)], 1u);
        const unsigned gen = old / nloc;
        if (old + 1u == (gen + 1u) * nloc) {
            __builtin_amdgcn_fence(__ATOMIC_RELEASE, "agent");
            asm volatile("s_waitcnt vmcnt(0)" ::: "memory");
            const unsigned og = xb_add(&bar[XB_TOP], 1u);
            const unsigned tg = og / nx;
            if (og + 1u == (tg + 1u) * nx) xb_add(&bar[XB_TOPGEN], 1u);
            else XB_SPIN(xb_ld(&bar[XB_TOPGEN]) == tg, bar);
            __builtin_amdgcn_fence(__ATOMIC_ACQUIRE, "agent");
            xb_add(&bar[XB_XGEN(b.x)], 1u);
            asm volatile("s_waitcnt vmcnt(0)" ::: "memory");
        } else {
            XB_SPIN(xb_ld(&bar[XB_XGEN(b.x)]) == gen, bar);
            __builtin_amdgcn_fence(__ATOMIC_ACQUIRE, "agent");
            asm volatile("s_waitcnt vmcnt(0)" ::: "memory");
        }
    }
    __syncthreads();
}

__global__ void __launch_bounds__(NTHR, 2) mk_fwd(Args a) {
    extern __shared__ __attribute__((aligned(16))) unsigned char lds_raw[];
    LAS unsigned char* lds = (LAS unsigned char*)lds_raw;
    const int tid = threadIdx.x, lane = tid & 63, wave = __builtin_amdgcn_readfirstlane(tid >> 6);
    const int bid = blockIdx.x, G = gridDim.x;
    const int gw = bid * NWAVES + wave, NGW = G * NWAVES;
    const int lo = a.ph_lo, hi = a.ph_hi;
    unsigned char* ws = a.ws;
    const float* mod0 = (const float*)(ws + WS_MOD);
    const float* mod1 = mod0 + 9 * MODW;
    bf16* ACT = (bf16*)(ws + WS_ACT); bf16* BIG = (bf16*)(ws + WS_BIG);
    float* XRC = (float*)(ws + WS_XRC);
#define IN(k) (lo <= (k) && (k) < hi)
    volatile LAS unsigned* xst = (volatile LAS unsigned*)(lds + LDS_BYTES - 128);
    if (tid < 32) xst[tid] = 0u;
    __syncthreads();
    XcdBarrier xbar; xbar.bar = (unsigned*)(ws + WS_CTL); xbar.x = 0; xbar.st = xst;
    if (hi - lo > 1) xbar = xcd_barrier_post((unsigned*)(ws + WS_CTL), xst);
#define SEAM(k) do { if (IN(k) && IN((k) + 1)) { xcd_barrier(xbar); } } while (0)
#define GEMM_PHASE(EPI, Ap, Btp, M_, N_, K_, E) do { const pg8::Gemm g_{(const pg8::bf16_t*)(Ap), (const pg8::bf16_t*)(Btp), (M_), (N_), (K_)}; pg8::StaticOrder S_; S_.init((M_), (N_), G, bid); \
        pg8::gemm_phase<EPI, pg8::StaticOrder, true, true>(lds, g_, S_, (E)); } while (0)

    if (IN(0)) { ph0_prologue(a, lds, tid, lane, wave, bid, G); } SEAM(0);
    if (IN(1)) { ph1_modulate(a, lane, gw, NGW); } SEAM(1);
    if (IN(2)) { const pg8::EpiB16<pg8::FnIn0> E{BIG, ABIN, pg8::FnIn0{(const float*)(ws + WS_ROPE)}}; GEMM_PHASE(pg8::EpiB16<pg8::FnIn0>, ACT, ws + WS_WABIN, MALL, ABIN, DM, E); } SEAM(2);
    if (IN(3)) {
        for (int it = bid; it < 544; it += G) l0_attn_unit(a, lds, it, tid, lane, wave);
        for (int it = G - 1 - bid; it < MALL / 128; it += G) l0_gate_chunk(a, lds, it, tid, lane, wave);
    } SEAM(3);
    if (IN(4)) { const pg8::EpiRes E{a.in[I_X], a.in[I_CTX], a.out, XRC, mod0 + 2 * DM}; GEMM_PHASE(pg8::EpiRes, ACT, ws + WS_WABOUT, MALL, DM, DM, E); } SEAM(4);
    if (IN(5)) { ph_layernorm(a, MALL, a.in[I_LN1G], a.in[I_LN1B], mod0 + 3 * DM, lane, gw, NGW); } SEAM(5);
    if (IN(6)) { const pg8::EpiB16<pg8::FnRelu2> E{BIG, FF, pg8::FnRelu2{}}; GEMM_PHASE(pg8::EpiB16<pg8::FnRelu2>, ACT, ws + WS_W1, MALL, FF, DM, E); } SEAM(6);
    if (IN(7)) { const pg8::EpiRes E{a.out, XRC, a.out, XRC, mod0 + 5 * DM}; GEMM_PHASE(pg8::EpiRes, BIG, ws + WS_W2, MALL, DM, FF, E); } SEAM(7);
    if (IN(8)) { ph_layernorm(a, MALL, a.in[I_LN2G], a.in[I_LN2B], mod1, lane, gw, NGW); } SEAM(8);
    if (IN(9)) { const pg8::EpiB16<pg8::FnIn1> E{BIG, CIN, pg8::FnIn1{}}; GEMM_PHASE(pg8::EpiB16<pg8::FnIn1>, ACT, ws + WS_WCIN, MALL, CIN, DM, E); } SEAM(9);
    if (IN(10)) { for (int it = bid; it < NBATCH * 16 * 16; it += G) l1_natten_unit(a, lds, it, tid, lane, wave); } SEAM(10);
    if (IN(11)) { const pg8::EpiRes E{a.out, XRC, a.out, XRC, mod1 + 2 * DM}; GEMM_PHASE(pg8::EpiRes, ACT, ws + WS_WCOUT, MLAT, DM, DM, E); } SEAM(11);
    if (IN(12)) { ph_layernorm(a, MLAT, a.in[I_LN1G] + DM, a.in[I_LN1B] + DM, mod1 + 3 * DM, lane, gw, NGW); } SEAM(12);
    if (IN(13)) { const pg8::EpiB16<pg8::FnRelu2> E{BIG, FF, pg8::FnRelu2{}}; GEMM_PHASE(pg8::EpiB16<pg8::FnRelu2>, ACT, ws + WS_W1 + 8 * MiB, MLAT, FF, DM, E); } SEAM(13);
    if (IN(14)) { const pg8::EpiRes E{a.out, XRC, a.out, XRC, mod1 + 5 * DM}; GEMM_PHASE(pg8::EpiRes, BIG, ws + WS_W2 + 8 * MiB, MLAT, DM, FF, E); } SEAM(14);
    if (IN(15)) { ph_layernorm(a, MLAT, a.in[I_LN2G] + DM, a.in[I_LN2B] + DM, nullptr, lane, gw, NGW); }
#undef IN
#undef SEAM
#undef GEMM_PHASE
}

extern "C" void kernel_launch(void* const* d_in, const int* in_sizes, int n_in, void* d_out, int out_size, void* d_ws, size_t ws_size, hipStream_t stream) {
    static int grid = 0;
    if (grid == 0) {
        if (n_in != 22 || in_sizes[0] != MLAT * DM || out_size != MLAT * DM || ws_size < WS_END) { fprintf(stderr, "kernel_launch: unexpected shapes (n_in %d, in0 %d, out %d, ws %zu)\n", n_in, n_in > 0 ? in_sizes[0] : -1, out_size, ws_size); grid = -1; return; }
        int dev = 0, cus = 0, per_cu = 0;
        if (hipGetDevice(&dev) != hipSuccess || hipDeviceGetAttribute(&cus, hipDeviceAttributeMultiprocessorCount, dev) != hipSuccess) { grid = -1; return; }
        if (hipFuncSetAttribute((const void*)mk_fwd, hipFuncAttributeMaxDynamicSharedMemorySize, LDS_BYTES) != hipSuccess) { fprintf(stderr, "kernel_launch: hipFuncSetAttribute failed\n"); grid = -1; return; }
        if (hipOccupancyMaxActiveBlocksPerMultiprocessor(&per_cu, (const void*)mk_fwd, NTHR, LDS_BYTES) != hipSuccess || per_cu < 1) { fprintf(stderr, "kernel_launch: occupancy query says %d blocks per CU\n", per_cu); per_cu = 1; }
        (void)hipGetLastError();
        grid = cus * (per_cu < 1 ? 1 : per_cu);
    }
    if (grid < 0) return;
    if (MK_N_LAUNCHES == 1 && hipMemsetAsync((char*)d_ws + WS_CTL, 0, 16384, stream) != hipSuccess) { fprintf(stderr, "kernel_launch: hipMemsetAsync failed\n"); return; }
    Args a{};
    for (int i = 0; i < 22; ++i) a.in[i] = (const float*)d_in[i];
    a.out = (float*)d_out; a.ws = (unsigned char*)d_ws;
    for (int i = 0; i < 16; ++i) a.freq[i] = powf(10000.0f, -(float)i / 16.0f);
    if (MK_N_LAUNCHES == 1) {
        a.ph_lo = 0; a.ph_hi = NPH;
        void* args[] = {&a};
        const hipError_t e = hipLaunchCooperativeKernel((const void*)mk_fwd, dim3(grid), dim3(NTHR), args, LDS_BYTES, stream);
        if (e != hipSuccess) fprintf(stderr, "kernel_launch: cooperative launch failed: %s (grid %d)\n", hipGetErrorString(e), grid);
    } else {
        for (int p = 0; p < NPH; ++p) { a.ph_lo = p; a.ph_hi = p + 1; hipLaunchKernelGGL(mk_fwd, dim3(grid), dim3(NTHR), LDS_BYTES, stream, a); }
    }
}
```

```cpp
#include <hip/hip_runtime.h>
#include <hip/hip_cooperative_groups.h>
#include <cstdio>
#include <cstdint>
namespace cg = cooperative_groups;

constexpr int DM = 1024, NBATCH = 8, SEQ = 4096, CTXL = 256;
constexpr int MLAT = NBATCH * SEQ;
constexpr int MCTX = NBATCH * CTXL;
constexpr int MALL = MLAT + MCTX;
constexpr int ABIN = 1792, CIN = 3072, FF = 4096, MODW = 6 * DM;
constexpr float LN_EPS = 1e-5f, ALPHA = 1.41421356237309515f;
namespace pg8 {
#define PG8_LAS __attribute__((address_space(3)))
typedef unsigned short bf16_t;
typedef short bf16x8 __attribute__((ext_vector_type(8)));
typedef float f32x4 __attribute__((ext_vector_type(4)));
typedef unsigned u32x4 __attribute__((ext_vector_type(4)));
constexpr int BM = 256, BK = 64, HALF = 128, HTB = HALF * BK * 2  , STAGE_BYTES = 8 * HTB, NXCD = 8, WGM = 8;

__host__ __device__ __forceinline__ int lds_byte(int r, int c) { const int st = (r >> 4) * 2 + (c >> 5), rr = r & 15, cc = c & 31, ob = rr * 64 + cc * 2; return st * 1024 + (ob ^ (((ob >> 9) & 1) << 5)); }
__host__ __device__ __forceinline__ void stage_rc(int b, int& R, int& C) { const int st = b / 1024, sb = b % 1024, swz = sb ^ (((sb >> 9) & 1) << 5); R = (st >> 1) * 16 + swz / 64; C = (st & 1) * 32 + (swz % 64) / 2; }
__host__ __device__ __forceinline__ int perm32(int rho) { const int n = rho >> 4, i = rho & 15; return 8 * (i >> 2) + 4 * n + (i & 3); }

struct Unit { int pm, pn, ko, ks; };
struct Gemm { const bf16_t* A; const bf16_t* Bt; int M, N, K, ld; };

struct StaticOrder {
    int nM, nN, nwg, G, c;
    __host__ __device__ void init(int M, int N, int G_, int c_) { nM = M / BM; nN = N / BM; nwg = nM * nN; G = G_; c = c_; }
    __host__ __device__ bool next(int i, Unit& u) const {
        const long L = (long)i * G + c; if (L >= nwg) return false;
        int wgid = (int)L; { const int q = nwg / NXCD, r = nwg % NXCD, xcd = wgid % NXCD, off = wgid / NXCD; wgid = (xcd < r ? xcd * (q + 1) : r * (q + 1) + (xcd - r) * q) + off; }
        const int nig = WGM * nN, gid = wgid / nig, fm = gid * WGM, gsz = (nM - fm) < WGM ? (nM - fm) : WGM;
        u.pm = fm + ((wgid % nig) % gsz); u.pn = (wgid % nig) / gsz; u.ko = 0; u.ks = 0; return true;
    }
    __device__ __forceinline__ void a_ready(const Unit&) const {}
    __device__ __forceinline__ void done(const Unit&) const {}
};

__device__ __forceinline__ unsigned cvt_pk_bf16(float lo, float hi) { unsigned r; asm volatile("v_cvt_pk_bf16_f32 %0, %1, %2" : "=v"(r) : "v"(lo), "v"(hi)); return r; }
typedef float f32x2 __attribute__((ext_vector_type(2)));
__device__ __forceinline__ float bf2f(unsigned short h) { return __uint_as_float((unsigned)h << 16); }
__device__ __forceinline__ float bflo(unsigned u) { return __uint_as_float(u << 16); }
__device__ __forceinline__ float bfhi(unsigned u) { return __uint_as_float(u & 0xffff0000u); }

__device__ __forceinline__ f32x2 gelu_pk(f32x2 v) {
    const f32x2 av = __builtin_elementwise_abs(v), d = av * 0.2316418882f + 1.0f;
    f32x2 t; t.x = __builtin_amdgcn_rcpf(d.x); t.y = __builtin_amdgcn_rcpf(d.y);
    f32x2 q = t * 0.5307027145f + (-0.7265760135f); q = q * t + 0.7107068705f; q = q * t + (-0.142248368f); q = q * t + 0.127414796f; q = q * t;
    const f32x2 s = (v * v) * (-0.72134752044f);
    f32x2 e; e.x = __builtin_amdgcn_exp2f(s.x); e.y = __builtin_amdgcn_exp2f(s.y);
    const f32x2 m = v * (q * e), r = v - m;
    f32x2 o; o.x = v.x < 0.f ? m.x : r.x; o.y = v.y < 0.f ? m.y : r.y; return o;
}
template <class Fn> struct EpiB16 {
    static constexpr bool PERM = true, AFTER_DRAIN = false;
    bf16_t* O; int ldc; Fn fn;
    __device__ __forceinline__ void operator()(const f32x4 (&acc)[2][2][4][2], const Unit& u, int wr, int wc, int fr, int fq) const {
        const int row0 = u.pm * BM + wr * 64 + fr, col0 = u.pn * BM + wc * 32 + 8 * fq;
#pragma unroll
        for (int ai = 0; ai < 2; ++ai)
#pragma unroll
            for (int m = 0; m < 4; ++m) { const int row = row0 + ai * HALF + m * 16;
#pragma unroll
                for (int bj = 0; bj < 2; ++bj) { const int col = col0 + bj * HALF;
                    float v[8];
#pragma unroll
                    for (int j = 0; j < 4; ++j) { v[j] = acc[ai][bj][m][0][j]; v[4 + j] = acc[ai][bj][m][1][j]; }
                    fn(row, col, v);
                    u32x4 w; w.x = cvt_pk_bf16(v[0], v[1]); w.y = cvt_pk_bf16(v[2], v[3]); w.z = cvt_pk_bf16(v[4], v[5]); w.w = cvt_pk_bf16(v[6], v[7]);
                    *(u32x4*)(O + (size_t)row * ldc + col) = w; } }
    }
};
struct FnIn0 {
    const float* rope;
    __device__ __forceinline__ void operator()(int row, int col, float (&v)[8]) const {
        if (col < 640) {
            if (row < MLAT) {
                const int s = row & (SEQ - 1), p0 = (col & 63) >> 1, pos = p0 < 16 ? (s >> 6) : (s & 63), f0 = p0 & 15;
                const f32x4* t = (const f32x4*)(rope + (pos * 16 + f0) * 2);
                const f32x4 t0 = t[0], t1 = t[1];
                const float c[4] = {t0[0], t0[2], t1[0], t1[2]}, sn[4] = {t0[1], t0[3], t1[1], t1[3]};
#pragma unroll
                for (int i = 0; i < 4; ++i) { const float x1 = v[2 * i], x2 = v[2 * i + 1]; v[2 * i] = x1 * c[i] - x2 * sn[i]; v[2 * i + 1] = x1 * sn[i] + x2 * c[i]; }
            }
            if (col < 512) {
#pragma unroll
                for (int j = 0; j < 8; ++j) v[j] *= 0.125f;
            }
        } else if (col >= 768) {
#pragma unroll
            for (int j = 0; j < 8; j += 2) { const f32x2 g2 = gelu_pk((f32x2){v[j], v[j + 1]}); v[j] = g2.x; v[j + 1] = g2.y; }
        }
    }
};
struct FnIn1 {
    __device__ __forceinline__ void operator()(int, int col, float (&v)[8]) const {
        if (col < DM) {
#pragma unroll
            for (int j = 0; j < 8; ++j) v[j] *= 0.125f;
        }
    }
};
struct FnRelu2 {
    __device__ __forceinline__ void operator()(int, int, float (&v)[8]) const {
#pragma unroll
        for (int j = 0; j < 8; ++j) { const float r = fmaxf(v[j], 0.f); v[j] = r * r; }
    }
};
struct EpiRes {
    static constexpr bool PERM = false, AFTER_DRAIN = false;
    const float* res_lat; const float* res_ctx; float* out_lat; float* out_ctx; const float* gate;
    __device__ __forceinline__ void operator()(const f32x4 (&acc)[2][2][4][2], const Unit& u, int wr, int wc, int fr, int fq) const {
        const int row0 = u.pm * BM + wr * 64 + fr, col0 = u.pn * BM + wc * 32 + 4 * fq;
        const int mr = u.pm < (MLAT / BM) ? (u.pm >> 4) : NBATCH;
        const float* g = gate + (size_t)mr * MODW;
        f32x4 gv[2][2];
#pragma unroll
        for (int bj = 0; bj < 2; ++bj)
#pragma unroll
            for (int n = 0; n < 2; ++n) gv[bj][n] = *(const f32x4*)(g + col0 + bj * HALF + n * 16);
#pragma unroll
        for (int ai = 0; ai < 2; ++ai)
#pragma unroll
            for (int m = 0; m < 4; ++m) { const int row = row0 + ai * HALF + m * 16;
                const float* rp; float* op;
                if (row < MLAT) { rp = res_lat + (size_t)row * DM; op = out_lat + (size_t)row * DM; } else { rp = res_ctx + (size_t)(row - MLAT) * DM; op = out_ctx + (size_t)(row - MLAT) * DM; }
#pragma unroll
                for (int bj = 0; bj < 2; ++bj)
#pragma unroll
                    for (int n = 0; n < 2; ++n) { const int c = col0 + bj * HALF + n * 16; const f32x4 x = *(const f32x4*)(rp + c);
                        *(f32x4*)(op + c) = x * ALPHA + gv[bj][n] * acc[ai][bj][m][n]; }
                if (m & 1) asm volatile("" ::: "memory"); }
    }
};

struct SplitOrder {
    int pm0, nN, nsplit, kbytes, total, G, c;
    __device__ __forceinline__ void init(int pm0_, int nPm, int nN_, int nsplit_, int kpart, int G_, int c_) { pm0 = pm0_; nN = nN_; nsplit = nsplit_; kbytes = kpart * 2; total = nPm * nN_ * nsplit_; G = G_; c = c_; }
    __device__ __forceinline__ bool next(int i, Unit& u) const { const int L = i * G + c; if (L >= total) return false; const int sp = L % nsplit, t = L / nsplit; u.pn = t % nN; u.pm = pm0 + t / nN; u.ko = sp * kbytes; u.ks = sp; return true; }
    __device__ __forceinline__ void a_ready(const Unit&) const {}
    __device__ __forceinline__ void done(const Unit&) const {}
};
struct EpiPart {
    static constexpr bool PERM = false, AFTER_DRAIN = false;
    float* P;
    __device__ __forceinline__ void operator()(const f32x4 (&acc)[2][2][4][2], const Unit& u, int wr, int wc, int fr, int fq) const {
        const int row0 = u.pm * BM - MLAT + wr * 64 + fr, col0 = u.pn * BM + wc * 32 + 4 * fq;
        float* base = P + (size_t)u.ks * MCTX * DM;
#pragma unroll
        for (int ai = 0; ai < 2; ++ai)
#pragma unroll
            for (int m = 0; m < 4; ++m) { float* rowp = base + (size_t)(row0 + ai * HALF + m * 16) * DM + col0;
#pragma unroll
                for (int bj = 0; bj < 2; ++bj)
#pragma unroll
                    for (int n = 0; n < 2; ++n) *(f32x4*)(rowp + bj * HALF + n * 16) = acc[ai][bj][m][n]; }
    }
};

template <class Epi, class Sched, bool ALIGN_EPI = false, bool SP2 = false>
__device__ __forceinline__ void gemm_phase(PG8_LAS unsigned char* lds, const Gemm g, const Sched& S, const Epi& E) {
    const int tid = threadIdx.x, wid = __builtin_amdgcn_readfirstlane(tid >> 6), lane = tid & 63, wr = wid >> 2, wc = wid & 3, fr = lane & 15, fq = lane >> 4;
    const int K = g.ld, nt = g.K / BK;
    unsigned voffA[2], voffB[2];
#pragma unroll
    for (int i = 0; i < 2; ++i) { int R, C; stage_rc(tid * 16 + i * 8192, R, C); const int Rb = Epi::PERM ? ((R & ~31) + perm32(R & 31)) : R;
        voffA[i] = (unsigned)(R * K + C) * 2u; voffB[i] = (unsigned)(Rb * K + C) * 2u; }
    const size_t kstep = (size_t)(BK * 2);
    const size_t hstep = (size_t)HALF * K * 2;
    const size_t tstep = 2 * hstep;
    const unsigned ldsw = (unsigned)wid * 1024u;
    const int aoff = lds_byte(wr * 64 + fr, fq * 8), boff = lds_byte(wc * 32 + fr, fq * 8);
#define PG8_SA(b, h) (((b) * 2 + (h)) * HTB)
#define PG8_SB(b, h) ((4 + (b) * 2 + (h)) * HTB)
#define PG8_STAGE(bufoff, gbase, voff) do { _Pragma("unroll") for (int _i = 0; _i < 2; ++_i) \
        __builtin_amdgcn_global_load_lds((const unsigned*)((const char*)(gbase) + (voff)[_i]), (PG8_LAS unsigned*)(lds + (bufoff) + ldsw + _i * 8192), 16, 0, 0); } while (0)
#define PG8_LDA(dst, b, h) do { _Pragma("unroll") for (int m = 0; m < 4; ++m) _Pragma("unroll") for (int k = 0; k < 2; ++k) dst[m][k] = *(const PG8_LAS bf16x8*)(lds + PG8_SA(b, h) + aoff + m * 2048 + k * 1024); } while (0)
#define PG8_LDB(dst, b, h) do { _Pragma("unroll") for (int n = 0; n < 2; ++n) _Pragma("unroll") for (int k = 0; k < 2; ++k) dst[n][k] = *(const PG8_LAS bf16x8*)(lds + PG8_SB(b, h) + boff + n * 2048 + k * 1024); } while (0)
#define PG8_MMA(ai, bj, At, Bt) do { __builtin_amdgcn_s_setprio(1); _Pragma("unroll") for (int m = 0; m < 4; ++m) _Pragma("unroll") for (int n = 0; n < 2; ++n) _Pragma("unroll") for (int k = 0; k < 2; ++k) \
        acc[ai][bj][m][n] = __builtin_amdgcn_mfma_f32_16x16x32_bf16(Bt[n][k], At[m][k], acc[ai][bj][m][n], 0, 0, 0); __builtin_amdgcn_s_setprio(0); } while (0)
#define PG8_WAIT_V(n) asm volatile("s_waitcnt vmcnt(" #n ")" ::: "memory")
#define PG8_WAIT_L(n) asm volatile("s_waitcnt lgkmcnt(" #n ")" ::: "memory")
#define PG8_BAR __builtin_amdgcn_s_barrier()
#define PG8_SCHED __builtin_amdgcn_sched_barrier(0)
    Unit cur, nxt; int ui = 0;
    if (!S.next(0, cur)) return;
    f32x4 acc[2][2][4][2];
#pragma unroll
    for (int a = 0; a < 2; ++a)
#pragma unroll
        for (int b = 0; b < 2; ++b)
#pragma unroll
            for (int m = 0; m < 4; ++m)
#pragma unroll
                for (int n = 0; n < 2; ++n) acc[a][b][m][n] = (f32x4){0.f, 0.f, 0.f, 0.f};
    bf16x8 At[4][2], B0[2][2], B1[2][2];
    const char* cA = (const char*)g.A + (size_t)cur.pm * tstep + cur.ko; const char* cB = (const char*)g.Bt + (size_t)cur.pn * tstep + cur.ko;
    S.a_ready(cur);
    if constexpr (SP2) {
        PG8_STAGE(PG8_SB(0, 0), cB, voffB); PG8_STAGE(PG8_SB(0, 1), cB + hstep, voffB); PG8_STAGE(PG8_SA(0, 0), cA, voffA); PG8_STAGE(PG8_SA(0, 1), cA + hstep, voffA);
        if (wr == 1) PG8_BAR;
        PG8_WAIT_V(2); PG8_BAR;
        PG8_STAGE(PG8_SB(1, 0), cB + kstep, voffB); PG8_STAGE(PG8_SA(1, 0), cA + kstep, voffA); PG8_STAGE(PG8_SB(1, 1), cB + hstep + kstep, voffB);
        PG8_WAIT_V(6); PG8_BAR;
    } else {
        PG8_STAGE(PG8_SB(0, 0), cB, voffB); PG8_STAGE(PG8_SA(0, 0), cA, voffA); PG8_STAGE(PG8_SB(0, 1), cB + hstep, voffB); PG8_STAGE(PG8_SA(0, 1), cA + hstep, voffA);
        if (wr == 1) PG8_BAR;
        PG8_WAIT_V(4); PG8_BAR;
        PG8_STAGE(PG8_SB(1, 0), cB + kstep, voffB); PG8_STAGE(PG8_SA(1, 0), cA + kstep, voffA); PG8_STAGE(PG8_SB(1, 1), cB + hstep + kstep, voffB);
        PG8_WAIT_V(6); PG8_BAR;
    }
    for (;;) {
        const bool has_next = S.next(ui + 1, nxt);
        const char* nA = has_next ? (const char*)g.A + (size_t)nxt.pm * tstep + nxt.ko : cA; const char* nB = has_next ? (const char*)g.Bt + (size_t)nxt.pn * tstep + nxt.ko : cB;
        for (int t = 0; t < nt; t += 2) {
            const bool last = (t == nt - 2);
            const char* a1 = cA + (size_t)(t + 1) * kstep;
            const char* a2 = last ? nA : cA + (size_t)(t + 2) * kstep; const char* b2 = last ? nB : cB + (size_t)(t + 2) * kstep;
            const char* a3 = a2 + kstep; const char* b3 = b2 + kstep;
            if (last && has_next) S.a_ready(nxt);
            if constexpr (SP2) {
            PG8_LDB(B0, 0, 0); PG8_LDB(B1, 0, 1); PG8_SCHED; PG8_LDA(At, 0, 0); PG8_STAGE(PG8_SA(1, 1), a1 + hstep, voffA);
            PG8_WAIT_V(8); PG8_WAIT_L(0); PG8_BAR; PG8_MMA(0, 0, At, B0); PG8_MMA(0, 1, At, B1); PG8_BAR; PG8_SCHED;
            PG8_LDA(At, 0, 1); PG8_STAGE(PG8_SB(0, 0), b2, voffB); PG8_STAGE(PG8_SB(0, 1), b2 + hstep, voffB); PG8_STAGE(PG8_SA(0, 0), a2, voffA);
            PG8_WAIT_V(8); PG8_WAIT_L(0); PG8_BAR; PG8_MMA(1, 0, At, B0); PG8_MMA(1, 1, At, B1); PG8_BAR; PG8_SCHED;
            PG8_LDB(B0, 1, 0); PG8_LDB(B1, 1, 1); PG8_SCHED; PG8_LDA(At, 1, 0); PG8_STAGE(PG8_SA(0, 1), a2 + hstep, voffA);
            PG8_WAIT_V(8); PG8_WAIT_L(0); PG8_BAR; PG8_MMA(0, 0, At, B0); PG8_MMA(0, 1, At, B1); PG8_BAR; PG8_SCHED;
            PG8_LDA(At, 1, 1); PG8_STAGE(PG8_SB(1, 0), b3, voffB); PG8_STAGE(PG8_SB(1, 1), b3 + hstep, voffB); PG8_STAGE(PG8_SA(1, 0), a3, voffA);
            PG8_WAIT_V(8); PG8_WAIT_L(0); PG8_BAR; PG8_MMA(1, 0, At, B0); PG8_MMA(1, 1, At, B1); PG8_BAR; PG8_SCHED;
            } else {
            PG8_LDB(B0, 0, 0); PG8_SCHED; PG8_LDA(At, 0, 0); PG8_STAGE(PG8_SA(1, 1), a1 + hstep, voffA);
            PG8_WAIT_L(8); PG8_BAR; PG8_WAIT_L(0); PG8_MMA(0, 0, At, B0); PG8_BAR; PG8_SCHED;
            PG8_LDB(B1, 0, 1); PG8_STAGE(PG8_SB(0, 0), b2, voffB);
            PG8_BAR; PG8_WAIT_L(0); PG8_MMA(0, 1, At, B1); PG8_BAR;
            PG8_LDA(At, 0, 1); PG8_STAGE(PG8_SA(0, 0), a2, voffA);
            PG8_BAR; PG8_WAIT_L(0); PG8_MMA(1, 0, At, B0); PG8_BAR; PG8_SCHED;
            PG8_STAGE(PG8_SB(0, 1), b2 + hstep, voffB);
            PG8_WAIT_V(6); PG8_BAR; PG8_MMA(1, 1, At, B1); PG8_BAR;
            PG8_LDB(B0, 1, 0); PG8_SCHED; PG8_LDA(At, 1, 0); PG8_STAGE(PG8_SA(0, 1), a2 + hstep, voffA);
            PG8_WAIT_L(8); PG8_BAR; PG8_WAIT_L(0); PG8_MMA(0, 0, At, B0); PG8_BAR; PG8_SCHED;
            PG8_LDB(B1, 1, 1); PG8_STAGE(PG8_SB(1, 0), b3, voffB);
            PG8_BAR; PG8_WAIT_L(0); PG8_MMA(0, 1, At, B1); PG8_BAR;
            PG8_LDA(At, 1, 1); PG8_STAGE(PG8_SA(1, 0), a3, voffA);
            PG8_BAR; PG8_WAIT_L(0); PG8_MMA(1, 0, At, B0); PG8_BAR; PG8_SCHED;
            PG8_STAGE(PG8_SB(1, 1), b3 + hstep, voffB);
            PG8_WAIT_V(6); PG8_BAR; PG8_MMA(1, 1, At, B1); PG8_BAR;
            }
        }
        if constexpr (ALIGN_EPI) { if (wr == 0) PG8_BAR; }
        if constexpr (!Epi::AFTER_DRAIN) { E(acc, cur, wr, wc, fr, fq); S.done(cur); }
        if (!has_next) break;
#pragma unroll
        for (int a = 0; a < 2; ++a)
#pragma unroll
            for (int b = 0; b < 2; ++b)
#pragma unroll
                for (int m = 0; m < 4; ++m)
#pragma unroll
                    for (int n = 0; n < 2; ++n) acc[a][b][m][n] = (f32x4){0.f, 0.f, 0.f, 0.f};
        cur = nxt; cA = nA; cB = nB; ++ui;
        if constexpr (ALIGN_EPI) { if (wr == 1) PG8_BAR; }
    }
    PG8_WAIT_V(0);
    if constexpr (!ALIGN_EPI) { if (wr == 0) PG8_BAR; }
    PG8_BAR;
    if constexpr (Epi::AFTER_DRAIN) { E.fused(acc, cur, wr, wc, fr, fq, lds, wid, lane); S.done(cur); }
#undef PG8_SA
#undef PG8_SB
#undef PG8_STAGE
#undef PG8_LDA
#undef PG8_LDB
#undef PG8_MMA
#undef PG8_WAIT_V
#undef PG8_WAIT_L
#undef PG8_BAR
#undef PG8_SCHED
}
}

#ifndef MK_N_LAUNCHES
#define MK_N_LAUNCHES 1
#endif
constexpr int NPH = 16;
constexpr int NWAVES = 8, NTHR = NWAVES * 64;
constexpr int LDS_BYTES = 147456;
#define LAS __attribute__((address_space(3)))
typedef unsigned short bf16;
typedef float f32x4 __attribute__((ext_vector_type(4)));
typedef unsigned v4u __attribute__((ext_vector_type(4)));
typedef unsigned v2u __attribute__((ext_vector_type(2)));
using pg8::bf2f; using pg8::bflo; using pg8::bfhi; using pg8::cvt_pk_bf16;

constexpr size_t MiB = 1u << 20;
constexpr size_t WS_CTL = 0, CTL_ZERO_BYTES = 1 * MiB;
constexpr size_t WS_MOD = 1 * MiB;
constexpr size_t WS_ROPE = 1 * MiB + 512 * 1024;
constexpr size_t WS_WABIN = 2 * MiB, WS_WABOUT = 6 * MiB, WS_WCIN = 8 * MiB, WS_WCOUT = 14 * MiB, WS_W1 = 16 * MiB, WS_W2 = 32 * MiB;
constexpr size_t WS_XRC = 48 * MiB;
constexpr size_t WS_ACT = 56 * MiB;
constexpr size_t WS_BIG = 128 * MiB;
constexpr size_t WS_PART = 400 * MiB;
constexpr size_t WS_END = 464 * MiB;
static_assert(WS_ACT + (size_t)MALL * DM * 2 <= WS_BIG && WS_BIG + (size_t)MALL * FF * 2 <= WS_PART && WS_PART + (size_t)8 * MCTX * DM * 4 <= WS_END, "d_ws map");

struct Args { const float* in[22]; float* out; unsigned char* ws; float freq[16]; int ph_lo, ph_hi; };
enum { I_X = 0, I_C, I_CTX, I_CCTX, I_WMOD, I_BMOD, I_ABWIN, I_SINK, I_BLNG, I_BLNB, I_BWS, I_BBS, I_ABWOUT, I_CWIN, I_RPB, I_CWOUT, I_LN1G, I_LN1B, I_W1, I_W2, I_LN2G, I_LN2B };

__device__ __forceinline__ float wave_sum(float v) {
#pragma unroll
    for (int o = 1; o < 64; o <<= 1) v += __shfl_xor(v, o);
    return v;
}
__device__ __forceinline__ unsigned f2bf(float f) { unsigned u = __builtin_bit_cast(unsigned, f); return (u + 0x7fffu + ((u >> 16) & 1u)) >> 16; }
__device__ __forceinline__ unsigned pk2(float lo, float hi) { return f2bf(lo) | (f2bf(hi) << 16); }

__device__ __forceinline__ void sincos_d(double x, double& s, double& c) {
    const double kd = rint(x * 0.63661977236758134308); const int k = (int)kd;
    const double r = (x - kd * 1.57079632679489655800) - kd * 6.12323399573676603587e-17, r2 = r * r;
    const double sp = r * (1.0 + r2 * (-1.0 / 6.0 + r2 * (1.0 / 120.0 + r2 * (-1.0 / 5040.0 + r2 * (1.0 / 362880.0 + r2 * (-1.0 / 39916800.0 + r2 * (1.0 / 6227020800.0 + r2 * (-1.0 / 1307674368000.0))))))));
    const double cp = 1.0 + r2 * (-0.5 + r2 * (1.0 / 24.0 + r2 * (-1.0 / 720.0 + r2 * (1.0 / 40320.0 + r2 * (-1.0 / 3628800.0 + r2 * (1.0 / 479001600.0 + r2 * (-1.0 / 87178291200.0 + r2 * (1.0 / 20922789888000.0))))))));
    const int q = k & 3;
    s = q == 0 ? sp : q == 1 ? cp : q == 2 ? -sp : -cp;
    c = q == 0 ? cp : q == 1 ? -sp : q == 2 ? -cp : sp;
}

__device__ __forceinline__ void p0_transpose_item(const float* W, int K, int N, bf16* WT, LAS float* scr, int item, int lane) {
    const int nblk = N / 32, kb = item / nblk, nb = item % nblk, k0 = 64 * kb, n0 = 32 * nb;
#pragma unroll 8
    for (int i = 0; i < 32; ++i) { const int kk = 2 * i + (lane >> 5); scr[kk * 33 + (lane & 31)] = W[(size_t)(k0 + kk) * N + n0 + (lane & 31)]; }
    asm volatile("s_waitcnt lgkmcnt(0)" ::: "memory");
    const int c = lane & 7;
#pragma unroll
    for (int j = 0; j < 4; ++j) { const int n = (lane >> 3) + 8 * j; const LAS float* s = scr + (8 * c) * 33 + n;
        v4u o; o.x = pk2(s[0 * 33], s[1 * 33]); o.y = pk2(s[2 * 33], s[3 * 33]); o.z = pk2(s[4 * 33], s[5 * 33]); o.w = pk2(s[6 * 33], s[7 * 33]);
        *(v4u*)(WT + (size_t)(n0 + n) * K + k0 + 8 * c) = o; }
    asm volatile("s_waitcnt lgkmcnt(0)" ::: "memory");
}

__device__ __forceinline__ void p0_mod_item(const Args& a, LAS unsigned char* lds, int item, int tid, int lane, int wave) {
    LAS float* sc = (LAS float*)lds;
    LAS float* red = sc + 9 * DM;
    const int l = item / 96, strip = item % 96;
    const float* c = a.in[I_C]; const float* cc = a.in[I_CCTX];
    for (int i = tid; i < 9 * DM; i += NTHR) { const int r = i >> 10, k = i & (DM - 1); const float v = r < NBATCH ? c[r * DM + k] : cc[k]; sc[i] = v / (1.0f + expf(-v)); }
    __syncthreads();
    const float* w = a.in[I_WMOD] + (size_t)l * DM * MODW + strip * 64 + lane;
    float acc[9];
#pragma unroll
    for (int r = 0; r < 9; ++r) acc[r] = 0.f;
    const int k0 = wave * 128;
#pragma unroll 4
    for (int k = k0; k < k0 + 128; ++k) { const float wv = w[(size_t)k * MODW];
#pragma unroll
        for (int r = 0; r < 9; ++r) acc[r] = fmaf(sc[r * DM + k], wv, acc[r]); }
#pragma unroll
    for (int r = 0; r < 9; ++r) red[(wave * 9 + r) * 64 + lane] = acc[r];
    __syncthreads();
    float* mod = (float*)(a.ws + WS_MOD);
    for (int i = tid; i < 9 * 64; i += NTHR) { const int r = i >> 6, ln = i & 63; float s = 0.f;
#pragma unroll
        for (int wv = 0; wv < 8; ++wv) s += red[(wv * 9 + r) * 64 + ln];
        const int n = strip * 64 + ln; mod[(size_t)(l * 9 + r) * MODW + n] = s + a.in[I_BMOD][l * MODW + n]; }
    __syncthreads();
}

__device__ __forceinline__ void ph0_prologue(const Args& a, LAS unsigned char* lds, int tid, int lane, int wave, int bid, int G) {
    if (bid == G - 1) {
        float* rope = (float*)(a.ws + WS_ROPE);
        for (int i = tid; i < 64 * 16; i += NTHR) { const int pos = i >> 4, f = i & 15; const float ang = (float)pos * a.freq[f]; double s, c; sincos_d((double)ang, s, c); rope[2 * i] = (float)c; rope[2 * i + 1] = (float)s; }
    }
    for (int item = bid; item < 192; item += G) p0_mod_item(a, lds, item, tid, lane, wave);
    LAS float* scr = (LAS float*)(lds + wave * 16384);
    const int gw = bid * NWAVES + wave, NGW = G * NWAVES;
    { bf16* wsb = (bf16*)(a.ws + (1 * MiB + 768 * 1024)); const float* src = a.in[I_BWS];
      for (int i = (gw * 64 + lane) * 4; i < 8 * 128 * 128; i += NGW * 64 * 4) { const f32x4 v = *(const f32x4*)(src + i); v2u o; o.x = pk2(v[0], v[1]); o.y = pk2(v[2], v[3]); *(v2u*)(wsb + i) = o; } }
    constexpr int I_A = (DM / 64) * (ABIN / 32), I_O = (DM / 64) * (DM / 32), I_CI = (DM / 64) * (CIN / 32), I_U = (DM / 64) * (FF / 32), I_D = (FF / 64) * (DM / 32);
    constexpr int NITEMS = I_A + I_O + I_CI + I_O + 2 * I_U + 2 * I_D;
    unsigned char* ws = a.ws;
    for (int it = gw; it < NITEMS; it += NGW) {
        int r = it;
        if (r < I_A) { p0_transpose_item(a.in[I_ABWIN], DM, ABIN, (bf16*)(ws + WS_WABIN), scr, r, lane); continue; } r -= I_A;
        if (r < I_O) { p0_transpose_item(a.in[I_ABWOUT], DM, DM, (bf16*)(ws + WS_WABOUT), scr, r, lane); continue; } r -= I_O;
        if (r < I_CI) { p0_transpose_item(a.in[I_CWIN], DM, CIN, (bf16*)(ws + WS_WCIN), scr, r, lane); continue; } r -= I_CI;
        if (r < I_O) { p0_transpose_item(a.in[I_CWOUT], DM, DM, (bf16*)(ws + WS_WCOUT), scr, r, lane); continue; } r -= I_O;
        if (r < 2 * I_U) { const int l = r / I_U; p0_transpose_item(a.in[I_W1] + (size_t)l * DM * FF, DM, FF, (bf16*)(ws + WS_W1 + (size_t)l * 8 * MiB), scr, r % I_U, lane); continue; } r -= 2 * I_U;
        { const int l = r / I_D; p0_transpose_item(a.in[I_W2] + (size_t)l * DM * FF, FF, DM, (bf16*)(ws + WS_W2 + (size_t)l * 8 * MiB), scr, r % I_D, lane); }
    }
}

__device__ __forceinline__ float* xr_row(const Args& a, int row) { return row < MLAT ? a.out + (size_t)row * DM : (float*)(a.ws + WS_XRC) + (size_t)(row - MLAT) * DM; }
__device__ __forceinline__ int mod_row(int row) { return row < MLAT ? (row >> 12) : NBATCH; }

__device__ __forceinline__ void ph1_modulate(const Args& a, int lane, int gw, int NGW) {
    const float* mod0 = (const float*)(a.ws + WS_MOD);
    bf16* act = (bf16*)(a.ws + WS_ACT);
    for (int row = gw; row < MALL; row += NGW) {
        const float* src = row < MLAT ? a.in[I_X] + (size_t)row * DM : a.in[I_CTX] + (size_t)(row - MLAT) * DM;
        const float* mr = mod0 + (size_t)mod_row(row) * MODW;
#pragma unroll
        for (int j = 0; j < 4; ++j) { const int c = 4 * lane + 256 * j; const f32x4 v = *(const f32x4*)(src + c), sh = *(const f32x4*)(mr + c), sc = *(const f32x4*)(mr + DM + c);
            const f32x4 h = v * (sc + 1.0f) + sh; v2u o; o.x = pk2(h[0], h[1]); o.y = pk2(h[2], h[3]); *(v2u*)(act + (size_t)row * DM + c) = o; }
    }
}

__device__ __forceinline__ void ph_layernorm(const Args& a, int nrows, const float* gam, const float* bet, const float* modv, int lane, int gw, int NGW) {
    bf16* act = (bf16*)(a.ws + WS_ACT);
    for (int row = gw; row < nrows; row += NGW) {
        float* xr = xr_row(a, row);
        f32x4 v[4]; float s = 0.f;
#pragma unroll
        for (int j = 0; j < 4; ++j) { v[j] = *(const f32x4*)(xr + 4 * lane + 256 * j); s += (v[j][0] + v[j][1]) + (v[j][2] + v[j][3]); }
        const float mean = wave_sum(s) * (1.0f / DM); float s2 = 0.f;
#pragma unroll
        for (int j = 0; j < 4; ++j) { v[j] = v[j] - mean; s2 += (v[j][0] * v[j][0] + v[j][1] * v[j][1]) + (v[j][2] * v[j][2] + v[j][3] * v[j][3]); }
        const float rstd = 1.0f / sqrtf(wave_sum(s2) * (1.0f / DM) + LN_EPS);
#pragma unroll
        for (int j = 0; j < 4; ++j) { const int c = 4 * lane + 256 * j; const f32x4 y = v[j] * rstd * *(const f32x4*)(gam + c) + *(const f32x4*)(bet + c);
            *(f32x4*)(xr + c) = y;
            if (modv) { const float* mr = modv + (size_t)mod_row(row) * MODW; const f32x4 h = y * (*(const f32x4*)(mr + DM + c) + 1.0f) + *(const f32x4*)(mr + c);
                v2u o; o.x = pk2(h[0], h[1]); o.y = pk2(h[2], h[3]); *(v2u*)(act + (size_t)row * DM + c) = o; } }
    }
}

__device__ __forceinline__ void ph_layernorm_ctx(const Args& a, const float* res, int nsplit, const float* gate, const float* gam, const float* bet, const float* modv, int lane, int gw, int NGW) {
    bf16* act = (bf16*)(a.ws + WS_ACT); const float* part = (const float*)(a.ws + WS_PART); float* xrc = (float*)(a.ws + WS_XRC);
    for (int r = gw; r < MCTX; r += NGW) {
        f32x4 v[4]; float s = 0.f;
#pragma unroll
        for (int j = 0; j < 4; ++j) { const int c = 4 * lane + 256 * j; f32x4 y = {0.f, 0.f, 0.f, 0.f};
            for (int sp = 0; sp < nsplit; ++sp) y = y + *(const f32x4*)(part + ((size_t)sp * MCTX + r) * DM + c);
            v[j] = *(const f32x4*)(res + (size_t)r * DM + c) * ALPHA + *(const f32x4*)(gate + c) * y; s += (v[j][0] + v[j][1]) + (v[j][2] + v[j][3]); }
        const float mean = wave_sum(s) * (1.0f / DM); float s2 = 0.f;
#pragma unroll
        for (int j = 0; j < 4; ++j) { v[j] = v[j] - mean; s2 += (v[j][0] * v[j][0] + v[j][1] * v[j][1]) + (v[j][2] * v[j][2] + v[j][3] * v[j][3]); }
        const float rstd = 1.0f / sqrtf(wave_sum(s2) * (1.0f / DM) + LN_EPS);
#pragma unroll
        for (int j = 0; j < 4; ++j) { const int c = 4 * lane + 256 * j; const f32x4 y = v[j] * rstd * *(const f32x4*)(gam + c) + *(const f32x4*)(bet + c);
            *(f32x4*)(xrc + (size_t)r * DM + c) = y;
            const f32x4 h = y * (*(const f32x4*)(modv + DM + c) + 1.0f) + *(const f32x4*)(modv + c);
            v2u o; o.x = pk2(h[0], h[1]); o.y = pk2(h[2], h[3]); *(v2u*)(act + (size_t)(MLAT + r) * DM + c) = o; }
    }
}

__device__ __forceinline__ void attn_key(const bf16* kp, const bf16* vp, bool valid, float bias, const float (&q)[64], float (&o)[64], float& m, float& l) {
    float dot = 0.f;
#pragma unroll
    for (int c = 0; c < 8; ++c) { const v4u kk = ((const v4u*)kp)[c];
        dot = fmaf(q[8 * c + 0], bflo(kk.x), dot); dot = fmaf(q[8 * c + 1], bfhi(kk.x), dot); dot = fmaf(q[8 * c + 2], bflo(kk.y), dot); dot = fmaf(q[8 * c + 3], bfhi(kk.y), dot);
        dot = fmaf(q[8 * c + 4], bflo(kk.z), dot); dot = fmaf(q[8 * c + 5], bfhi(kk.z), dot); dot = fmaf(q[8 * c + 6], bflo(kk.w), dot); dot = fmaf(q[8 * c + 7], bfhi(kk.w), dot); }
    const float sc = valid ? dot + bias : -1e30f;
    const float mn = fmaxf(m, sc), corr = __expf(m - mn), p = __expf(sc - mn);
    l = l * corr + p; m = mn;
#pragma unroll
    for (int c = 0; c < 8; ++c) { const v4u vv = ((const v4u*)vp)[c];
        o[8 * c + 0] = fmaf(o[8 * c + 0], corr, p * bflo(vv.x)); o[8 * c + 1] = fmaf(o[8 * c + 1], corr, p * bfhi(vv.x)); o[8 * c + 2] = fmaf(o[8 * c + 2], corr, p * bflo(vv.y)); o[8 * c + 3] = fmaf(o[8 * c + 3], corr, p * bfhi(vv.y));
        o[8 * c + 4] = fmaf(o[8 * c + 4], corr, p * bflo(vv.z)); o[8 * c + 5] = fmaf(o[8 * c + 5], corr, p * bfhi(vv.z)); o[8 * c + 6] = fmaf(o[8 * c + 6], corr, p * bflo(vv.w)); o[8 * c + 7] = fmaf(o[8 * c + 7], corr, p * bfhi(vv.w)); }
}
__device__ __forceinline__ void load_q64(const bf16* qp, float (&q)[64]) {
#pragma unroll
    for (int c = 0; c < 8; ++c) { const v4u t = ((const v4u*)qp)[c]; q[8 * c + 0] = bflo(t.x); q[8 * c + 1] = bfhi(t.x); q[8 * c + 2] = bflo(t.y); q[8 * c + 3] = bfhi(t.y); q[8 * c + 4] = bflo(t.z); q[8 * c + 5] = bfhi(t.z); q[8 * c + 6] = bflo(t.w); q[8 * c + 7] = bfhi(t.w); }
}
__device__ __forceinline__ void store_o64(bf16* op, const float (&o)[64], float inv) {
#pragma unroll
    for (int c = 0; c < 8; ++c) { v4u w; w.x = pk2(o[8 * c + 0] * inv, o[8 * c + 1] * inv); w.y = pk2(o[8 * c + 2] * inv, o[8 * c + 3] * inv); w.z = pk2(o[8 * c + 4] * inv, o[8 * c + 5] * inv); w.w = pk2(o[8 * c + 6] * inv, o[8 * c + 7] * inv); ((v4u*)op)[c] = w; }
}
__device__ __forceinline__ void l0_attn_item_naive(const Args& a, int item, int lane, int wave) {
    const bf16* Z = (const bf16*)(a.ws + WS_BIG); bf16* AB = (bf16*)(a.ws + WS_ACT);
    const int row = item * 64 + lane, h = wave, hkv = h >> 2;
    const bool latent = item < MLAT / 64;
    const int b = latent ? item >> 6 : (item - MLAT / 64) >> 2;
    float q[64], o[64];
    load_q64(Z + (size_t)row * ABIN + 64 * h, q);
#pragma unroll
    for (int d = 0; d < 64; ++d) o[d] = 0.f;
    float m = a.in[I_SINK][h], l = 1.0f;
    const bf16* kc = Z + (size_t)(MLAT + b * CTXL) * ABIN + 512 + 64 * hkv;
    for (int j = 0; j < CTXL; ++j) attn_key(kc + (size_t)j * ABIN, kc + (size_t)j * ABIN + 128, true, 0.f, q, o, m, l);
    if (latent) {
        const int s0 = (item & 63) * 64, s = s0 + lane, lo = s0 - 128 < 0 ? 0 : s0 - 128, hi = s0 + 191 > SEQ - 1 ? SEQ - 1 : s0 + 191;
        const bf16* kl = Z + (size_t)(b * SEQ) * ABIN + 512 + 64 * hkv;
        for (int kp = lo; kp <= hi; ++kp) { const int d = s - kp; attn_key(kl + (size_t)kp * ABIN, kl + (size_t)kp * ABIN + 128, d <= 128 && d >= -128, 0.f, q, o, m, l); }
    }
    store_o64(AB + (size_t)row * DM + 64 * h, o, 1.0f / l);
}
__device__ __forceinline__ void l0_gate_chunk_naive(const Args& a, LAS unsigned char* lds, int chunk, int tid, int lane, int wave) {
    const bf16* Z = (const bf16*)(a.ws + WS_BIG); bf16* AB = (bf16*)(a.ws + WS_ACT);
    LAS float* st = (LAS float*)lds;
    LAS float* vn = st + 256;
    const int base = chunk * 128;
    for (int i = 0; i < 16; ++i) { const int r = wave * 16 + i; const v4u t = *(const v4u*)(Z + (size_t)(base + r) * ABIN + 1280 + lane * 8);
        float x[8] = {bflo(t.x), bfhi(t.x), bflo(t.y), bfhi(t.y), bflo(t.z), bfhi(t.z), bflo(t.w), bfhi(t.w)}; float s = 0.f;
#pragma unroll
        for (int j = 0; j < 8; ++j) s += x[j];
        const float mean = wave_sum(s) * (1.0f / 512.0f); float s2 = 0.f;
#pragma unroll
        for (int j = 0; j < 8; ++j) { const float d = x[j] - mean; s2 += d * d; }
        const float var = wave_sum(s2) * (1.0f / 512.0f);
        if (lane == 0) { st[2 * r] = mean; st[2 * r + 1] = 1.0f / sqrtf(var + LN_EPS); } }
    __syncthreads();
    const float* wsg = a.in[I_BWS]; const float* bs = a.in[I_BBS];
    for (int g = 0; g < 8; ++g) {
        { const int c = tid & 63; const float lg = a.in[I_BLNG][g * 64 + c], lb = a.in[I_BLNB][g * 64 + c];
          for (int i = 0; i < 16; ++i) { const int qq = (tid >> 6) + 8 * i; const float x = bf2f(Z[(size_t)(base + qq) * ABIN + 1280 + g * 64 + c]); vn[qq * 64 + c] = (x - st[2 * qq]) * st[2 * qq + 1] * lg + lb; } }
        __syncthreads();
        float acc[16];
#pragma unroll
        for (int j = 0; j < 16; ++j) acc[j] = 0.f;
        const float* wrow = wsg + (size_t)(g * 128 + wave * 16) * 128;
        for (int qq = 0; qq < 128; ++qq) { const float v = vn[qq * 64 + lane];
#pragma unroll
            for (int j = 0; j < 16; ++j) acc[j] = fmaf(wrow[j * 128 + qq], v, acc[j]); }
#pragma unroll
        for (int j = 0; j < 16; ++j) { const int p = wave * 16 + j; const size_t row = (size_t)(base + p); const float mixed = acc[j] + bs[g * 128 + p]; const float u = bf2f(Z[row * ABIN + 768 + g * 64 + lane]);
            AB[row * DM + 512 + g * 64 + lane] = (bf16)f2bf(u * mixed); }
        __syncthreads();
    }
}
__device__ __forceinline__ void l1_natten_item_naive(const Args& a, int item, int lane, int wave) {
    const bf16* Z = (const bf16*)(a.ws + WS_BIG); bf16* AC = (bf16*)(a.ws + WS_ACT);
    const int rg = item >> 1, h = (item & 1) * 8 + wave, row = rg * 64 + lane, b = rg >> 6, r = rg & 63, c = lane;
    const int r0 = r - 4 < 0 ? 0 : (r - 4 > 56 ? 56 : r - 4), qs = c - 8 < 0 ? 0 : (c - 8 > 48 ? 48 : c - 8);
    float q[64], o[64];
    load_q64(Z + (size_t)row * CIN + 64 * h, q);
#pragma unroll
    for (int d = 0; d < 64; ++d) o[d] = 0.f;
    float m = -1e30f, l = 0.f;
    const bf16* kc = Z + (size_t)(MLAT + b * CTXL) * CIN + DM + 64 * h;
    for (int j = 0; j < CTXL; ++j) attn_key(kc + (size_t)j * CIN, kc + (size_t)j * CIN + DM, true, 0.f, q, o, m, l);
    const float* rpb = a.in[I_RPB] + h * 465;
    for (int kr = r0; kr < r0 + 8; ++kr) {
        const bf16* kl = Z + (size_t)(b * SEQ + kr * 64) * CIN + DM + 64 * h; const float* brow = rpb + (kr - r + 7) * 31;
        for (int kcx = 0; kcx < 64; ++kcx) { int dc = kcx - c + 15; dc = dc < 0 ? 0 : (dc > 30 ? 30 : dc);
            attn_key(kl + (size_t)kcx * CIN, kl + (size_t)kcx * CIN + DM, kcx >= qs && kcx < qs + 16, brow[dc], q, o, m, l); }
    }
    store_o64(AC + (size_t)row * DM + 64 * h, o, 1.0f / l);
}


typedef float f32x16 __attribute__((ext_vector_type(16)));
typedef short bf16x8 __attribute__((ext_vector_type(8)));
typedef short s16x4 __attribute__((ext_vector_type(4)));
constexpr int KP = 144;
constexpr int TILE_B = 64 * KP;
constexpr float LOG2E = 1.4426950408889634f;
__device__ __forceinline__ int crow(int r, int hi) { return (r & 3) + 8 * (r >> 2) + 4 * hi; }
__device__ __forceinline__ s16x4 tr_read(const LAS unsigned char* p) { return __builtin_bit_cast(s16x4, __builtin_amdgcn_ds_read_tr16_b64_v4i16((LAS s16x4*)p)); }
struct QT { f32x16 o0, o1; float m, l; };
struct MfNone { __device__ __forceinline__ float operator()(float s, int, int) const { return s * LOG2E; } };
struct MfWin { int dq;
    __device__ __forceinline__ float operator()(float s, int r, int hi) const { const int d = dq - crow(r, hi); return (d > 128 || d < -128) ? -1e30f : s * LOG2E; } };
struct MfNat { const LAS float* brow; int cq, qs, kc0; bool rowok;
    __device__ __forceinline__ float operator()(float s, int r, int hi) const { const int kc = kc0 + crow(r, hi); int dc = kc - cq + 15; dc = dc < 0 ? 0 : (dc > 30 ? 30 : dc);
        const bool ok = rowok && kc >= qs && kc < qs + 16; return ok ? (s + brow[dc]) * LOG2E : -1e30f; } };
template <class MF> __device__ __forceinline__ void attn_sub32(const LAS unsigned char* Ks, const LAS unsigned char* Vs, const bf16x8 (&qf)[4], QT& st, int lane, const MF& mf) {
    const int r32 = lane & 31, hi = lane >> 5;
    f32x16 s;
#pragma unroll
    for (int r = 0; r < 16; ++r) s[r] = 0.f;
    const LAS unsigned char* kp = Ks + r32 * KP + hi * 16;
#pragma unroll
    for (int ks = 0; ks < 4; ++ks) { const bf16x8 kf = *(const LAS bf16x8*)(kp + ks * 32); s = __builtin_amdgcn_mfma_f32_32x32x16_bf16(kf, qf[ks], s, 0, 0, 0); }
    float mx = -1e30f;
#pragma unroll
    for (int r = 0; r < 16; ++r) { const float t = mf(s[r], r, hi); s[r] = t; mx = fmaxf(mx, t); }
    mx = fmaxf(mx, __shfl_xor(mx, 32));
    const float mn = fmaxf(st.m, mx), corr = __builtin_amdgcn_exp2f(st.m - mn);
    st.m = mn; st.l *= corr; st.o0 = st.o0 * corr; st.o1 = st.o1 * corr;
    float ps = 0.f;
#pragma unroll
    for (int r = 0; r < 16; ++r) { const float p = __builtin_amdgcn_exp2f(s[r] - mn); s[r] = p; ps += p; }
    st.l += ps;
    const int g = lane >> 4, i = lane & 15;
    const LAS unsigned char* vp = Vs + (4 * (g >> 1) + (i >> 2)) * KP + (16 * (g & 1) + 4 * (i & 3)) * 2;
#pragma unroll
    for (int sp = 0; sp < 2; ++sp) {
        v4u pw; pw.x = cvt_pk_bf16(s[8 * sp + 0], s[8 * sp + 1]); pw.y = cvt_pk_bf16(s[8 * sp + 2], s[8 * sp + 3]); pw.z = cvt_pk_bf16(s[8 * sp + 4], s[8 * sp + 5]); pw.w = cvt_pk_bf16(s[8 * sp + 6], s[8 * sp + 7]);
        const bf16x8 pf = __builtin_bit_cast(bf16x8, pw);
        { const s16x4 lo = tr_read(vp + (16 * sp) * KP), hi4 = tr_read(vp + (16 * sp + 8) * KP); const bf16x8 vf = {lo[0], lo[1], lo[2], lo[3], hi4[0], hi4[1], hi4[2], hi4[3]};
          st.o0 = __builtin_amdgcn_mfma_f32_32x32x16_bf16(vf, pf, st.o0, 0, 0, 0); }
        { const s16x4 lo = tr_read(vp + (16 * sp) * KP + 64), hi4 = tr_read(vp + (16 * sp + 8) * KP + 64); const bf16x8 vf = {lo[0], lo[1], lo[2], lo[3], hi4[0], hi4[1], hi4[2], hi4[3]};
          st.o1 = __builtin_amdgcn_mfma_f32_32x32x16_bf16(vf, pf, st.o1, 0, 0, 0); }
    }
}
__device__ __forceinline__ void qt_init(QT& st, float m0, float l0) {
#pragma unroll
    for (int r = 0; r < 16; ++r) { st.o0[r] = 0.f; st.o1[r] = 0.f; }
    st.m = m0; st.l = l0;
}
__device__ __forceinline__ void qt_store(const QT& st, bf16* orow, int lane) {
    const int hi = lane >> 5; const float lt = st.l + __shfl_xor(st.l, 32), inv = 1.0f / lt;
#pragma unroll
    for (int gq = 0; gq < 4; ++gq) {
        v2u w0; w0.x = cvt_pk_bf16(st.o0[4 * gq + 0] * inv, st.o0[4 * gq + 1] * inv); w0.y = cvt_pk_bf16(st.o0[4 * gq + 2] * inv, st.o0[4 * gq + 3] * inv); *(v2u*)(orow + 8 * gq + 4 * hi) = w0;
        v2u w1; w1.x = cvt_pk_bf16(st.o1[4 * gq + 0] * inv, st.o1[4 * gq + 1] * inv); w1.y = cvt_pk_bf16(st.o1[4 * gq + 2] * inv, st.o1[4 * gq + 3] * inv); *(v2u*)(orow + 32 + 8 * gq + 4 * hi) = w1; }
}
__device__ __forceinline__ void l0_attn_unit(const Args& a, LAS unsigned char* lds, int unit, int tid, int lane, int wave) {
    const bf16* Z = (const bf16*)(a.ws + WS_BIG); bf16* AB = (bf16*)(a.ws + WS_ACT);
    const bool latent = unit < 512;
    int b, hkv, qb; if (latent) { b = unit >> 6; hkv = (unit >> 5) & 1; qb = unit & 31; } else { const int u2 = unit - 512; b = u2 >> 2; hkv = (u2 >> 1) & 1; qb = u2 & 1; }
    const int qrow0 = latent ? b * SEQ + qb * 128 : MLAT + b * CTXL + qb * 128;
    const int h = hkv * 4 + (wave >> 1), qw = 64 * (wave & 1), r32 = lane & 31, hi = lane >> 5;
    bf16x8 qf[2][4]; QT st[2];
#pragma unroll
    for (int qt = 0; qt < 2; ++qt) { const bf16* qp = Z + (size_t)(qrow0 + qw + 32 * qt + r32) * ABIN + 64 * h + 8 * hi;
#pragma unroll
        for (int ks = 0; ks < 4; ++ks) qf[qt][ks] = *(const bf16x8*)(qp + 16 * ks);
        qt_init(st[qt], a.in[I_SINK][h] * LOG2E, hi == 0 ? 1.0f : 0.0f); }
    const int s0 = qb * 128; int klo = 0, nloc = 0;
    if (latent) { klo = s0 - 128 < 0 ? 0 : s0 - 128; const int khi = s0 + 256 > SEQ ? SEQ : s0 + 256; nloc = (khi - klo) >> 6; }
    const int ntiles = 4 + nloc, key = tid >> 3, ch = tid & 7;
    const bf16* kbase = Z + 512 + 64 * hkv + 8 * ch;
    v4u kreg, vreg;
    { const bf16* p = kbase + (size_t)(MLAT + b * CTXL + key) * ABIN; kreg = *(const v4u*)p; vreg = *(const v4u*)(p + 128); }
    for (int t = 0; t < ntiles; ++t) {
        LAS unsigned char* Kt = lds + (t & 1) * (2 * TILE_B); LAS unsigned char* Vt = Kt + TILE_B;
        *(LAS v4u*)(Kt + key * KP + ch * 16) = kreg; *(LAS v4u*)(Vt + key * KP + ch * 16) = vreg;
        __syncthreads();
        if (t + 1 < ntiles) { const int rb = (t + 1 < 4) ? MLAT + b * CTXL + 64 * (t + 1) : b * SEQ + klo + 64 * (t + 1 - 4); const bf16* p = kbase + (size_t)(rb + key) * ABIN; kreg = *(const v4u*)p; vreg = *(const v4u*)(p + 128); }
#pragma unroll
        for (int qt = 0; qt < 2; ++qt)
#pragma unroll 1
            for (int sub = 0; sub < 2; ++sub) {
                const LAS unsigned char* Ks = Kt + 32 * sub * KP; const LAS unsigned char* Vs = Vt + 32 * sub * KP;
                if (t < 4) attn_sub32(Ks, Vs, qf[qt], st[qt], lane, MfNone{});
                else { const int sq0 = s0 + qw + 32 * qt, kp0 = klo + 64 * (t - 4) + 32 * sub;
                    if (kp0 - (sq0 + 31) > 128 || sq0 - (kp0 + 31) > 128) continue;
                    if ((sq0 + 31) - kp0 <= 128 && (kp0 + 31) - sq0 <= 128) attn_sub32(Ks, Vs, qf[qt], st[qt], lane, MfNone{});
                    else attn_sub32(Ks, Vs, qf[qt], st[qt], lane, MfWin{sq0 + r32 - kp0}); }
            }
    }
#pragma unroll
    for (int qt = 0; qt < 2; ++qt) qt_store(st[qt], AB + (size_t)(qrow0 + qw + 32 * qt + r32) * DM + 64 * h, lane);
    __syncthreads();
}
__device__ __forceinline__ void l1_natten_unit(const Args& a, LAS unsigned char* lds, int unit, int tid, int lane, int wave) {
    const bf16* Z = (const bf16*)(a.ws + WS_BIG); bf16* AC = (bf16*)(a.ws + WS_ACT);
    const int r4 = (unit & 15) * 4, h = (unit >> 4) & 15, b = unit >> 8;
    LAS float* btab = (LAS float*)(lds + 4 * TILE_B);
    for (int i = tid; i < 465; i += NTHR) btab[i] = a.in[I_RPB][h * 465 + i];
    const int rp = wave >> 2, j = wave & 3, r32 = lane & 31, hi = lane >> 5;
    const int r = r4 + 2 * rp + ((lane >> 4) & 1), c = 16 * j + (lane & 15), qrow = b * SEQ + r * 64 + c;
    const int r0l = r - 4 < 0 ? 0 : (r - 4 > 56 ? 56 : r - 4), qs = c - 8 < 0 ? 0 : (c - 8 > 48 ? 48 : c - 8);
    const int kc0 = 16 * j - 8 < 0 ? 0 : (16 * j - 8 > 32 ? 32 : 16 * j - 8);
    const int ra = r4 + 2 * rp, rb = ra + 1;
    const int r0a = ra - 4 < 0 ? 0 : (ra - 4 > 56 ? 56 : ra - 4), r0b = rb - 4 < 0 ? 0 : (rb - 4 > 56 ? 56 : rb - 4);
    bf16x8 qf[4]; QT st;
    { const bf16* qp = Z + (size_t)qrow * CIN + 64 * h + 8 * hi;
#pragma unroll
      for (int ks = 0; ks < 4; ++ks) qf[ks] = *(const bf16x8*)(qp + 16 * ks); }
    qt_init(st, -1e30f, 0.f);
    const int krlo = r4 - 4 < 0 ? 0 : (r4 - 4 > 56 ? 56 : r4 - 4); const int krhi = (r4 - 1 < 0 ? 0 : (r4 - 1 > 56 ? 56 : r4 - 1)) + 8;
    const int ntiles = 4 + (krhi - krlo), key = tid >> 3, ch = tid & 7;
    const bf16* kbase = Z + DM + 64 * h + 8 * ch;
    v4u kreg, vreg;
    { const bf16* p = kbase + (size_t)(MLAT + b * CTXL + key) * CIN; kreg = *(const v4u*)p; vreg = *(const v4u*)(p + DM); }
    for (int t = 0; t < ntiles; ++t) {
        LAS unsigned char* Kt = lds + (t & 1) * (2 * TILE_B); LAS unsigned char* Vt = Kt + TILE_B;
        *(LAS v4u*)(Kt + key * KP + ch * 16) = kreg; *(LAS v4u*)(Vt + key * KP + ch * 16) = vreg;
        __syncthreads();
        if (t + 1 < ntiles) { const int rbs = (t + 1 < 4) ? MLAT + b * CTXL + 64 * (t + 1) : b * SEQ + (krlo + t + 1 - 4) * 64; const bf16* p = kbase + (size_t)(rbs + key) * CIN; kreg = *(const v4u*)p; vreg = *(const v4u*)(p + DM); }
        if (t < 4) { attn_sub32(Kt, Vt, qf, st, lane, MfNone{}); attn_sub32(Kt + 32 * KP, Vt + 32 * KP, qf, st, lane, MfNone{}); }
        else { const int kr = krlo + t - 4;
            if ((kr >= r0a && kr < r0a + 8) || (kr >= r0b && kr < r0b + 8)) { int dr = kr - r + 7; dr = dr < 0 ? 0 : (dr > 14 ? 14 : dr);
                attn_sub32(Kt + kc0 * KP, Vt + kc0 * KP, qf, st, lane, MfNat{btab + dr * 31, c, qs, kc0, kr >= r0l && kr < r0l + 8}); } }
    }
    qt_store(st, AC + (size_t)qrow * DM + 64 * h, lane);
    __syncthreads();
}


constexpr int VNP = 136;
constexpr size_t WS_WSB = 1 * MiB + 768 * 1024;
__device__ __forceinline__ void l0_gate_chunk(const Args& a, LAS unsigned char* lds, int chunk, int tid, int lane, int wave) {
    const bf16* Z = (const bf16*)(a.ws + WS_BIG); bf16* AB = (bf16*)(a.ws + WS_ACT);
    LAS float* st = (LAS float*)(lds + 8 * 128 * VNP);
    LAS unsigned char* vn = lds + wave * (128 * VNP);
    const int base = chunk * 128, g = wave;
    for (int i = 0; i < 16; ++i) { const int r = wave * 16 + i; const v4u t = *(const v4u*)(Z + (size_t)(base + r) * ABIN + 1280 + lane * 8);
        float x[8] = {bflo(t.x), bfhi(t.x), bflo(t.y), bfhi(t.y), bflo(t.z), bfhi(t.z), bflo(t.w), bfhi(t.w)}; float s = 0.f;
#pragma unroll
        for (int j = 0; j < 8; ++j) s += x[j];
        const float mean = wave_sum(s) * (1.0f / 512.0f); float s2 = 0.f;
#pragma unroll
        for (int j = 0; j < 8; ++j) { const float d = x[j] - mean; s2 += d * d; }
        const float var = wave_sum(s2) * (1.0f / 512.0f);
        if (lane == 0) { st[2 * r] = mean; st[2 * r + 1] = 1.0f / sqrtf(var + LN_EPS); } }
    __syncthreads();
    { const int ch = lane & 7, c0 = 64 * g + 8 * ch; float lg[8], lb[8];
#pragma unroll
      for (int j = 0; j < 8; ++j) { lg[j] = a.in[I_BLNG][c0 + j]; lb[j] = a.in[I_BLNB][c0 + j]; }
#pragma unroll 4
      for (int i = 0; i < 16; ++i) { const int q = i * 8 + (lane >> 3); const v4u t = *(const v4u*)(Z + (size_t)(base + q) * ABIN + 1280 + c0);
          const float mean = st[2 * q], rstd = st[2 * q + 1];
          float x[8] = {bflo(t.x), bfhi(t.x), bflo(t.y), bfhi(t.y), bflo(t.z), bfhi(t.z), bflo(t.w), bfhi(t.w)};
#pragma unroll
          for (int j = 0; j < 8; ++j) x[j] = (x[j] - mean) * rstd * lg[j] + lb[j];
          v2u w0, w1; w0.x = cvt_pk_bf16(x[0], x[1]); w0.y = cvt_pk_bf16(x[2], x[3]); w1.x = cvt_pk_bf16(x[4], x[5]); w1.y = cvt_pk_bf16(x[6], x[7]);
          *(LAS v2u*)(vn + q * VNP + ch * 16) = w0; *(LAS v2u*)(vn + q * VNP + ch * 16 + 8) = w1; } }
    asm volatile("s_waitcnt lgkmcnt(0)" ::: "memory");
    const int r32 = lane & 31, hi = lane >> 5, g4 = lane >> 4, i15 = lane & 15;
    const LAS unsigned char* vp = vn + (8 * (g4 >> 1) + (i15 >> 2)) * VNP + (16 * (g4 & 1) + 4 * (i15 & 3)) * 2;
    const bf16* wsb = (const bf16*)(a.ws + WS_WSB) + (size_t)g * 128 * 128;
    const float* bs = a.in[I_BBS] + g * 128;
#pragma unroll 1
    for (int pt = 0; pt < 4; ++pt) {
        f32x16 acc0, acc1;
#pragma unroll
        for (int r = 0; r < 16; ++r) { acc0[r] = 0.f; acc1[r] = 0.f; }
        const bf16* wp = wsb + (size_t)(32 * pt + r32) * 128 + 8 * hi;
#pragma unroll
        for (int ks = 0; ks < 8; ++ks) { const bf16x8 wf = *(const bf16x8*)(wp + 16 * ks);
            { const s16x4 lo = tr_read(vp + (16 * ks) * VNP), h4 = tr_read(vp + (16 * ks + 4) * VNP); const bf16x8 vf = {lo[0], lo[1], lo[2], lo[3], h4[0], h4[1], h4[2], h4[3]};
              acc0 = __builtin_amdgcn_mfma_f32_32x32x16_bf16(vf, wf, acc0, 0, 0, 0); }
            { const s16x4 lo = tr_read(vp + (16 * ks) * VNP + 64), h4 = tr_read(vp + (16 * ks + 4) * VNP + 64); const bf16x8 vf = {lo[0], lo[1], lo[2], lo[3], h4[0], h4[1], h4[2], h4[3]};
              acc1 = __builtin_amdgcn_mfma_f32_32x32x16_bf16(vf, wf, acc1, 0, 0, 0); } }
        const int p = 32 * pt + r32; const size_t row = (size_t)(base + p); const float bsp = bs[p];
        const bf16* up = Z + row * ABIN + 768 + 64 * g + 4 * hi; bf16* op = AB + row * DM + 512 + 64 * g + 4 * hi;
#pragma unroll
        for (int gq = 0; gq < 4; ++gq) {
            { const v2u u = *(const v2u*)(up + 8 * gq); v2u w; w.x = cvt_pk_bf16(bflo(u.x) * (acc0[4 * gq + 0] + bsp), bfhi(u.x) * (acc0[4 * gq + 1] + bsp)); w.y = cvt_pk_bf16(bflo(u.y) * (acc0[4 * gq + 2] + bsp), bfhi(u.y) * (acc0[4 * gq + 3] + bsp)); *(v2u*)(op + 8 * gq) = w; }
            { const v2u u = *(const v2u*)(up + 32 + 8 * gq); v2u w; w.x = cvt_pk_bf16(bflo(u.x) * (acc1[4 * gq + 0] + bsp), bfhi(u.x) * (acc1[4 * gq + 1] + bsp)); w.y = cvt_pk_bf16(bflo(u.y) * (acc1[4 * gq + 2] + bsp), bfhi(u.y) * (acc1[4 * gq + 3] + bsp)); *(v2u*)(op + 32 + 8 * gq) = w; } }
    }
    __syncthreads();
}


#define XB_TMO      128
#define XB_XCNT(j)  (256  + 64 * (j))
#define XB_XSUB(j)  (1280 + 64 * (j))
#define XB_XGEN(j)  (2304 + 64 * (j))
#define XB_TOP      3328
#define XB_TOPGEN   3392
#define XCD_BAR_WORDS 3456
#define XB_SPIN_CAP (1u << 18)
__device__ __forceinline__ unsigned xb_ld(unsigned* p)              { return __hip_atomic_load(p, __ATOMIC_RELAXED, __HIP_MEMORY_SCOPE_AGENT); }
__device__ __forceinline__ unsigned xb_add(unsigned* p, unsigned v) { return __hip_atomic_fetch_add(p, v, __ATOMIC_RELAXED, __HIP_MEMORY_SCOPE_AGENT); }
__device__ __forceinline__ unsigned xb_xcc_id() { return (unsigned)__builtin_amdgcn_s_getreg((3 << 11) | 20) & 0xFu; }
#define XB_SPIN(cond, bar) do { unsigned _sp = 0; while (cond) { __builtin_amdgcn_s_sleep(1); \
    if ((++_sp & 255u) == 0u) { if (xb_ld(&(bar)[XB_TMO])) break; if (_sp > XB_SPIN_CAP) { atomicAdd(&(bar)[XB_TMO], 1u); break; } } } } while (0)
struct XcdBarrier { unsigned* bar; unsigned x; volatile LAS unsigned* st; };
__device__ __forceinline__ XcdBarrier xcd_barrier_post(unsigned* bar, volatile LAS unsigned* st) {
    XcdBarrier b; b.bar = bar; b.x = xb_xcc_id(); b.st = st;
    if (threadIdx.x == 0) (void)xb_add(&bar[XB_XCNT(b.x)], 1u);
    return b;
}
__device__ __forceinline__ void xcd_barrier_complete(unsigned* bar, unsigned x, unsigned& nloc, unsigned& nx) {
    const unsigned G = gridDim.x * gridDim.y * gridDim.z;
    unsigned sum, cnt, mine, sp = 0u;
    for (;;) {
        sum = 0u; cnt = 0u; mine = 0u;
#pragma unroll
        for (unsigned j = 0; j < 16; ++j) { const unsigned c = xb_ld(&bar[XB_XCNT(j)]); sum += c; cnt += (c > 0u) ? 1u : 0u; mine = (j == x) ? c : mine; }
        if (sum == G) break;
        __builtin_amdgcn_s_sleep(1);
        if ((++sp & 255u) == 0u) { if (xb_ld(&bar[XB_TMO])) break; if (sp > XB_SPIN_CAP) { atomicAdd(&bar[XB_TMO], 1u); break; } }
    }
    nloc = mine > 0u ? mine : 1u; nx = cnt > 0u ? cnt : 1u;
}
__device__ __forceinline__ void xcd_barrier(const XcdBarrier& b) {
    asm volatile("s_waitcnt vmcnt(0)" ::: "memory");
    __syncthreads();
    if (threadIdx.x == 0) {
        unsigned* bar = b.bar;
        __builtin_amdgcn_s_waitcnt(0);
        unsigned nloc = b.st[0], nx = b.st[1];
        if (nloc == 0u) { xcd_barrier_complete(bar, b.x, nloc, nx); b.st[0] = nloc; b.st[1] = nx; }
        const unsigned old = xb_add(&bar[XB_XSUB(b.x)], 1u);
        const unsigned gen = old / nloc;
        if (old + 1u == (gen + 1u) * nloc) {
            __builtin_amdgcn_fence(__ATOMIC_RELEASE, "agent");
            asm volatile("s_waitcnt vmcnt(0)" ::: "memory");
            const unsigned og = xb_add(&bar[XB_TOP], 1u);
            const unsigned tg = og / nx;
            if (og + 1u == (tg + 1u) * nx) xb_add(&bar[XB_TOPGEN], 1u);
            else XB_SPIN(xb_ld(&bar[XB_TOPGEN]) == tg, bar);
            __builtin_amdgcn_fence(__ATOMIC_ACQUIRE, "agent");
            xb_add(&bar[XB_XGEN(b.x)], 1u);
            asm volatile("s_waitcnt vmcnt(0)" ::: "memory");
        } else {
            XB_SPIN(xb_ld(&bar[XB_XGEN(b.x)]) == gen, bar);
            __builtin_amdgcn_fence(__ATOMIC_ACQUIRE, "agent");
            asm volatile("s_waitcnt vmcnt(0)" ::: "memory");
        }
    }
    __syncthreads();
}

__global__ void __launch_bounds__(NTHR, 2) mk_fwd(Args a) {
    extern __shared__ __attribute__((aligned(16))) unsigned char lds_raw[];
    LAS unsigned char* lds = (LAS unsigned char*)lds_raw;
    const int tid = threadIdx.x, lane = tid & 63, wave = __builtin_amdgcn_readfirstlane(tid >> 6);
    const int bid = blockIdx.x, G = gridDim.x;
    const int gw = bid * NWAVES + wave, NGW = G * NWAVES;
    const int lo = a.ph_lo, hi = a.ph_hi;
    unsigned char* ws = a.ws;
    const float* mod0 = (const float*)(ws + WS_MOD);
    const float* mod1 = mod0 + 9 * MODW;
    bf16* ACT = (bf16*)(ws + WS_ACT); bf16* BIG = (bf16*)(ws + WS_BIG);
    float* XRC = (float*)(ws + WS_XRC);
#ifndef PROBE_MASK
#define PROBE_MASK 0
#endif
#define IN(k) (lo <= (k) && (k) < hi)
#define REP(k) for (int rep_ = 0; rep_ < (((PROBE_MASK) >> (k)) & 1) + 1; ++rep_)
    volatile LAS unsigned* xst = (volatile LAS unsigned*)(lds + LDS_BYTES - 128);
    if (tid < 32) xst[tid] = 0u;
    __syncthreads();
    XcdBarrier xbar; xbar.bar = (unsigned*)(ws + WS_CTL); xbar.x = 0; xbar.st = xst;
    if (hi - lo > 1) xbar = xcd_barrier_post((unsigned*)(ws + WS_CTL), xst);
#define SEAM(k) do { if (IN(k) && IN((k) + 1)) { xcd_barrier(xbar); } } while (0)
#define GEMM_PHASE(EPI, Ap, Btp, M_, N_, K_, E) do { const pg8::Gemm g_{(const pg8::bf16_t*)(Ap), (const pg8::bf16_t*)(Btp), (M_), (N_), (K_), (K_)}; pg8::StaticOrder S_; S_.init((M_), (N_), G, bid); \
        pg8::gemm_phase<EPI, pg8::StaticOrder, true, true>(lds, g_, S_, (E)); } while (0)

#define GEMM_SPLIT(Ap, Btp, LD_, NSPLIT_) do { const pg8::Gemm g_{(const pg8::bf16_t*)(Ap), (const pg8::bf16_t*)(Btp), MALL, DM, (LD_) / (NSPLIT_), (LD_)}; pg8::SplitOrder S_; S_.init(MLAT / 256, MCTX / 256, DM / 256, (NSPLIT_), (LD_) / (NSPLIT_), G, bid); \
        const pg8::EpiPart E_{(float*)(ws + WS_PART)}; pg8::gemm_phase<pg8::EpiPart, pg8::SplitOrder, true, true>(lds, g_, S_, E_); } while (0)
    if (IN(0)) { ph0_prologue(a, lds, tid, lane, wave, bid, G); } SEAM(0);
    if (IN(1)) { ph1_modulate(a, lane, gw, NGW); } SEAM(1);
    if (IN(2)) REP(2) { const pg8::EpiB16<pg8::FnIn0> E{BIG, ABIN, pg8::FnIn0{(const float*)(ws + WS_ROPE)}}; GEMM_PHASE(pg8::EpiB16<pg8::FnIn0>, ACT, ws + WS_WABIN, MALL, ABIN, DM, E); } SEAM(2);
    if (IN(3)) REP(3) {
        for (int it = bid; it < 544; it += G) l0_attn_unit(a, lds, it, tid, lane, wave);
        for (int it = G - 1 - bid; it < MALL / 128; it += G) l0_gate_chunk(a, lds, it, tid, lane, wave);
    } SEAM(3);
    if (IN(4)) REP(4) { const pg8::EpiRes E{a.in[I_X], a.in[I_CTX], a.out, XRC, mod0 + 2 * DM}; GEMM_PHASE(pg8::EpiRes, ACT, ws + WS_WABOUT, MLAT, DM, DM, E); GEMM_SPLIT(ACT, ws + WS_WABOUT, DM, 4); } SEAM(4);
    if (IN(5)) { ph_layernorm(a, MLAT, a.in[I_LN1G], a.in[I_LN1B], mod0 + 3 * DM, lane, gw, NGW);
        ph_layernorm_ctx(a, a.in[I_CTX], 4, mod0 + 8 * MODW + 2 * DM, a.in[I_LN1G], a.in[I_LN1B], mod0 + 8 * MODW + 3 * DM, lane, NGW - 1 - gw, NGW); } SEAM(5);
    if (IN(6)) REP(6) { const pg8::EpiB16<pg8::FnRelu2> E{BIG, FF, pg8::FnRelu2{}}; GEMM_PHASE(pg8::EpiB16<pg8::FnRelu2>, ACT, ws + WS_W1, MALL, FF, DM, E); } SEAM(6);
    if (IN(7)) { const pg8::EpiRes E{a.out, XRC, a.out, XRC, mod0 + 5 * DM}; GEMM_PHASE(pg8::EpiRes, BIG, ws + WS_W2, MLAT, DM, FF, E); GEMM_SPLIT(BIG, ws + WS_W2, FF, 8); } SEAM(7);
    if (IN(8)) { ph_layernorm(a, MLAT, a.in[I_LN2G], a.in[I_LN2B], mod1, lane, gw, NGW);
        ph_layernorm_ctx(a, XRC, 8, mod0 + 8 * MODW + 5 * DM, a.in[I_LN2G], a.in[I_LN2B], mod1 + 8 * MODW, lane, NGW - 1 - gw, NGW); } SEAM(8);
    if (IN(9)) REP(9) { const pg8::EpiB16<pg8::FnIn1> E{BIG, CIN, pg8::FnIn1{}}; GEMM_PHASE(pg8::EpiB16<pg8::FnIn1>, ACT, ws + WS_WCIN, MALL, CIN, DM, E); } SEAM(9);
    if (IN(10)) REP(10) { for (int it = bid; it < NBATCH * 16 * 16; it += G) l1_natten_unit(a, lds, it, tid, lane, wave); } SEAM(10);
    if (IN(11)) { const pg8::EpiRes E{a.out, XRC, a.out, XRC, mod1 + 2 * DM}; GEMM_PHASE(pg8::EpiRes, ACT, ws + WS_WCOUT, MLAT, DM, DM, E); } SEAM(11);
    if (IN(12)) { ph_layernorm(a, MLAT, a.in[I_LN1G] + DM, a.in[I_LN1B] + DM, mod1 + 3 * DM, lane, gw, NGW); } SEAM(12);
    if (IN(13)) REP(13) { const pg8::EpiB16<pg8::FnRelu2> E{BIG, FF, pg8::FnRelu2{}}; GEMM_PHASE(pg8::EpiB16<pg8::FnRelu2>, ACT, ws + WS_W1 + 8 * MiB, MLAT, FF, DM, E); } SEAM(13);
    if (IN(14)) { const pg8::EpiRes E{a.out, XRC, a.out, XRC, mod1 + 5 * DM}; GEMM_PHASE(pg8::EpiRes, BIG, ws + WS_W2 + 8 * MiB, MLAT, DM, FF, E); } SEAM(14);
    if (IN(15)) { ph_layernorm(a, MLAT, a.in[I_LN2G] + DM, a.in[I_LN2B] + DM, nullptr, lane, gw, NGW); }
#undef IN
#undef SEAM
#undef GEMM_SPLIT
#undef GEMM_PHASE
}

extern "C" void kernel_launch(void* const* d_in, const int* in_sizes, int n_in, void* d_out, int out_size, void* d_ws, size_t ws_size, hipStream_t stream) {
    static int grid = 0;
    if (grid == 0) {
        if (n_in != 22 || in_sizes[0] != MLAT * DM || out_size != MLAT * DM || ws_size < WS_END) { fprintf(stderr, "kernel_launch: unexpected shapes (n_in %d, in0 %d, out %d, ws %zu)\n", n_in, n_in > 0 ? in_sizes[0] : -1, out_size, ws_size); grid = -1; return; }
        int dev = 0, cus = 0, per_cu = 0;
        if (hipGetDevice(&dev) != hipSuccess || hipDeviceGetAttribute(&cus, hipDeviceAttributeMultiprocessorCount, dev) != hipSuccess) { grid = -1; return; }
        if (hipFuncSetAttribute((const void*)mk_fwd, hipFuncAttributeMaxDynamicSharedMemorySize, LDS_BYTES) != hipSuccess) { fprintf(stderr, "kernel_launch: hipFuncSetAttribute failed\n"); grid = -1; return; }
        if (hipOccupancyMaxActiveBlocksPerMultiprocessor(&per_cu, (const void*)mk_fwd, NTHR, LDS_BYTES) != hipSuccess || per_cu < 1) { fprintf(stderr, "kernel_launch: occupancy query says %d blocks per CU\n", per_cu); per_cu = 1; }
        (void)hipGetLastError();
        grid = cus * (per_cu < 1 ? 1 : per_cu);
    }
    if (grid < 0) return;
    if (MK_N_LAUNCHES == 1 && hipMemsetAsync((char*)d_ws + WS_CTL, 0, 16384, stream) != hipSuccess) { fprintf(stderr, "kernel_launch: hipMemsetAsync failed\n"); return; }
    Args a{};
    for (int i = 0; i < 22; ++i) a.in[i] = (const float*)d_in[i];
    a.out = (float*)d_out; a.ws = (unsigned char*)d_ws;
    for (int i = 0; i < 16; ++i) a.freq[i] = powf(10000.0f, -(float)i / 16.0f);
    if (MK_N_LAUNCHES == 1) {
        a.ph_lo = 0; a.ph_hi = NPH;
        void* args[] = {&a};
        const hipError_t e = hipLaunchCooperativeKernel((const void*)mk_fwd, dim3(grid), dim3(NTHR), args, LDS_BYTES, stream);
        if (e != hipSuccess) fprintf(stderr, "kernel_launch: cooperative launch failed: %s (grid %d)\n", hipGetErrorString(e), grid);
    } else {
        for (int p = 0; p < NPH; ++p) { a.ph_lo = p; a.ph_hi = p + 1; hipLaunchKernelGGL(mk_fwd, dim3(grid), dim3(NTHR), LDS_BYTES, stream, a); }
    }
}
```
